# Optimizing an MI355X kernel written in HIP

```python
import math
import jax
import jax.numpy as jnp
from jax import lax
import numpy as np

D_MODEL = 1024
BATCH = 4
SEQ = 8192
DEPTH = 2

HEAD_DIM = 64
Q_BLOCK = 128
N_FOX_HEADS = 8
DIL_PAIRS = ((128, 1), (512, 4), (2048, 16))
N_DIL_GROUPS = 3
N_DIL_SLOTS = 4
N_DIL_HEADS = N_DIL_GROUPS * N_DIL_SLOTS
N_DSA_HEADS = 16
KV_RANK = 256
N_IDX_HEADS = 8
IDX_DIM = 64
DSA_TOPK = 256
N_BUCKETS = 32
MAX_DISTANCE = 2048
N_BIAS_HEADS = 16
N_EXPERTS = 32
TOP_K = 4
D_EXPERT = 1024
SWIGLU_ALPHA = 1.702
SWIGLU_LIMIT = 7.0
MOE_CHUNK = 256
EPS = 1e-6

FOX_QKV = 3 * N_FOX_HEADS * HEAD_DIM
DIL_QKV = 3 * N_DIL_HEADS * HEAD_DIM
EVEN_IN = FOX_QKV + N_FOX_HEADS + DIL_QKV
EVEN_OUT = (N_FOX_HEADS + N_DIL_SLOTS) * HEAD_DIM
DSA_Q = N_DSA_HEADS * HEAD_DIM
IDX_Q = N_IDX_HEADS * IDX_DIM
ODD_IN = DSA_Q + KV_RANK + IDX_Q + IDX_DIM + N_IDX_HEADS
ODD_OUT = DSA_Q

kernel_name = "hybrid_fox_dilated_dsa_moe_adaln"


def rmsnorm(x, g):
    xf = x.astype(jnp.float32)
    y = xf * lax.rsqrt(jnp.mean(xf * xf, axis=-1, keepdims=True) + EPS)
    return (y * g.astype(jnp.float32)).astype(x.dtype)


def t5_bucket(dist):
    max_exact = N_BUCKETS // 2
    d = jnp.maximum(dist, 0)
    df = jnp.maximum(d, 1).astype(jnp.float32)
    large = max_exact + (jnp.log(df / max_exact) / math.log(MAX_DISTANCE / max_exact)
                         * (N_BUCKETS - max_exact)).astype(jnp.int32)
    large = jnp.minimum(large, N_BUCKETS - 1)
    return jnp.where(d < max_exact, d, large)


def forgetting_attention(q, k, v, log_f):
    b, s, h, hd = q.shape
    scale = hd ** -0.5
    cum = jnp.cumsum(log_f, axis=1).transpose(0, 2, 1)
    kpos = jnp.arange(s)

    def block(i):
        start = i * Q_BLOCK
        qpos = start + jnp.arange(Q_BLOCK)
        qb = lax.dynamic_slice_in_dim(q, start, Q_BLOCK, axis=1)
        cq = lax.dynamic_slice_in_dim(cum, start, Q_BLOCK, axis=2)
        sc = jnp.einsum('bqhd,bkhd->bhqk', qb, k, preferred_element_type=jnp.float32) * scale
        sc = sc + (cq[..., :, None] - cum[..., None, :])
        sc = jnp.where(kpos[None, :] <= qpos[:, None], sc, -jnp.inf)
        p = jax.nn.softmax(sc, axis=-1)
        return jnp.einsum('bhqk,bkhd->bqhd', p.astype(v.dtype), v)

    out = lax.map(block, jnp.arange(s // Q_BLOCK))
    return out.transpose(1, 0, 2, 3, 4).reshape(b, s, h, hd)


def dilated_attention(q, k, v, rel_bias):
    b, s, _, _, hd = q.shape
    scale = hd ** -0.5
    ks = [k[:, :, g] for g in range(N_DIL_GROUPS)]
    vs = [v[:, :, g] for g in range(N_DIL_GROUPS)]
    offsets, biases = [], []
    for g, (window, dil) in enumerate(DIL_PAIRS):
        dist = jnp.arange(window // dil + 1) * dil
        offsets.append(dist)
        tab = rel_bias[t5_bucket(dist)][:, g * N_DIL_SLOTS:(g + 1) * N_DIL_SLOTS]
        biases.append(tab.T.astype(jnp.float32))

    def block(i):
        start = i * Q_BLOCK
        qpos = start + jnp.arange(Q_BLOCK)
        qb = lax.dynamic_slice_in_dim(q, start, Q_BLOCK, axis=1)
        outs, lses = [], []
        for g in range(N_DIL_GROUPS):
            kp = qpos[:, None] - offsets[g][None, :]
            valid = kp >= 0
            kidx = jnp.maximum(kp, 0)
            kg = ks[g][:, kidx]
            vg = vs[g][:, kidx]
            sc = jnp.einsum('bqjd,bqnjd->bjqn', qb[:, :, g], kg,
                            preferred_element_type=jnp.float32) * scale
            sc = jnp.where(valid[None, None], sc + biases[g][None, :, None, :], -jnp.inf)
            mx = jnp.max(sc, axis=-1, keepdims=True)
            e = jnp.exp(sc - mx)
            den = jnp.sum(e, axis=-1, keepdims=True)
            outs.append(jnp.einsum('bjqn,bqnjd->bqjd', (e / den).astype(vg.dtype), vg))
            lses.append((mx + jnp.log(den))[..., 0])
        alpha = jax.nn.softmax(jnp.stack(lses), axis=0)
        return sum(alpha[g].transpose(0, 2, 1)[..., None].astype(outs[g].dtype) * outs[g]
                   for g in range(N_DIL_GROUPS))

    out = lax.map(block, jnp.arange(s // Q_BLOCK))
    return out.transpose(1, 0, 2, 3, 4).reshape(b, s, N_DIL_SLOTS, hd)


def dsa_attention(q, k, v, q_idx, k_idx, w_idx, rel_bias):
    b, s, h, hd = q.shape
    n_sel = min(DSA_TOPK, s // 4)
    scale = hd ** -0.5
    idx_scale = (N_IDX_HEADS * IDX_DIM) ** -0.5
    kpos = jnp.arange(s)

    def block(i):
        start = i * Q_BLOCK
        qpos = start + jnp.arange(Q_BLOCK)
        qi = lax.dynamic_slice_in_dim(q_idx, start, Q_BLOCK, axis=1)
        wi = lax.dynamic_slice_in_dim(w_idx, start, Q_BLOCK, axis=1)
        dots = jnp.einsum('bqhd,bkd->bqhk', qi, k_idx, preferred_element_type=jnp.float32)
        score = jnp.einsum('bqh,bqhk->bqk', wi.astype(jnp.float32), jax.nn.relu(dots)) * idx_scale
        score = jnp.where(kpos[None, None, :] <= qpos[None, :, None], score, -jnp.inf)
        _, sel = lax.top_k(score, n_sel)
        valid = sel <= qpos[None, :, None]
        kb = jax.vmap(lambda kk, ss: kk[ss])(k, sel)
        vb = jax.vmap(lambda vv, ss: vv[ss])(v, sel)
        qb = lax.dynamic_slice_in_dim(q, start, Q_BLOCK, axis=1)
        sc = jnp.einsum('bqhd,bqnhd->bhqn', qb, kb, preferred_element_type=jnp.float32) * scale
        bias = rel_bias[t5_bucket(qpos[None, :, None] - sel)].astype(jnp.float32)
        sc = jnp.where(valid[:, None], sc + bias.transpose(0, 3, 1, 2), -jnp.inf)
        p = jax.nn.softmax(sc, axis=-1)
        return jnp.einsum('bhqn,bqnhd->bqhd', p.astype(vb.dtype), vb)

    out = lax.map(block, jnp.arange(s // Q_BLOCK))
    return out.transpose(1, 0, 2, 3, 4).reshape(b, s, h, hd)


def even_mixer(h, w_in, fox_fb, w_out, rel_bias):
    b, s, _ = h.shape
    proj = h @ w_in
    fox_qkv, fox_f, dil_qkv = jnp.split(proj, [FOX_QKV, FOX_QKV + N_FOX_HEADS], axis=-1)
    fq, fk, fv = (t.reshape(b, s, N_FOX_HEADS, HEAD_DIM) for t in jnp.split(fox_qkv, 3, axis=-1))
    log_f = jax.nn.log_sigmoid((fox_f + fox_fb).astype(jnp.float32))
    fox_out = forgetting_attention(fq, fk, fv, log_f)
    dq, dk, dv = (t.reshape(b, s, N_DIL_GROUPS, N_DIL_SLOTS, HEAD_DIM)
                  for t in jnp.split(dil_qkv, 3, axis=-1))
    dil_out = dilated_attention(dq, dk, dv, rel_bias)
    merged = jnp.concatenate([fox_out.reshape(b, s, -1), dil_out.reshape(b, s, -1)], axis=-1)
    return merged @ w_out


def odd_mixer(h, w_in, kv_norm, w_ukv, w_out, rel_bias):
    b, s, _ = h.shape
    proj = h @ w_in
    q, ckv, qi, ki, wi = jnp.split(
        proj, [DSA_Q, DSA_Q + KV_RANK, DSA_Q + KV_RANK + IDX_Q, DSA_Q + KV_RANK + IDX_Q + IDX_DIM],
        axis=-1)
    kv = rmsnorm(ckv, kv_norm) @ w_ukv
    k, v = (t.reshape(b, s, N_DSA_HEADS, HEAD_DIM) for t in jnp.split(kv, 2, axis=-1))
    q = q.reshape(b, s, N_DSA_HEADS, HEAD_DIM)
    qi = qi.reshape(b, s, N_IDX_HEADS, IDX_DIM)
    out = dsa_attention(q, k, v, qi, ki, wi, rel_bias)
    return out.reshape(b, s, -1) @ w_out


def moe_ffn(h, router_w, router_b, w1, b1, w2, b2):
    b, s, d = h.shape
    xt = h.reshape(-1, d)
    n = xt.shape[0]
    logits = (xt @ router_w + router_b).astype(jnp.float32)
    top_vals, top_idx = lax.top_k(logits, TOP_K)
    gates = jax.nn.softmax(top_vals, axis=-1)
    flat_e = top_idx.reshape(-1)
    flat_tok = jnp.repeat(jnp.arange(n, dtype=jnp.int32), TOP_K)
    flat_g = gates.reshape(-1)
    order = jnp.argsort(flat_e)
    e_sorted, tok_sorted, g_sorted = flat_e[order], flat_tok[order], flat_g[order]
    counts = jnp.bincount(flat_e, length=N_EXPERTS)
    padded = ((counts + MOE_CHUNK - 1) // MOE_CHUNK) * MOE_CHUNK
    start_raw = jnp.cumsum(counts) - counts
    ends_pad = jnp.cumsum(padded)
    start_pad = ends_pad - padded
    dest = start_pad[e_sorted] + (jnp.arange(n * TOP_K) - start_raw[e_sorted])
    n_chunks = -(-(n * TOP_K) // MOE_CHUNK) + N_EXPERTS
    rows = n_chunks * MOE_CHUNK
    row_tok = jnp.full((rows,), n, dtype=jnp.int32).at[dest].set(tok_sorted)
    row_gate = jnp.zeros((rows,), jnp.float32).at[dest].set(g_sorted)
    chunk_exp = jnp.minimum(
        jnp.searchsorted(ends_pad, jnp.arange(n_chunks) * MOE_CHUNK, side='right'), N_EXPERTS - 1)
    x_pad = jnp.concatenate([xt, jnp.zeros((1, d), xt.dtype)], axis=0)

    def run_chunk(args):
        toks, e = args
        hm = x_pad[toks] @ w1[e] + b1[e]
        glu = jnp.minimum(hm[:, :D_EXPERT], SWIGLU_LIMIT)
        lin = jnp.clip(hm[:, D_EXPERT:], -SWIGLU_LIMIT, SWIGLU_LIMIT)
        act = glu * jax.nn.sigmoid(SWIGLU_ALPHA * glu) * (lin + 1.0)
        return act @ w2[e] + b2[e]

    y = lax.map(run_chunk, (row_tok.reshape(n_chunks, MOE_CHUNK), chunk_exp))
    y = y.reshape(rows, d) * row_gate[:, None].astype(y.dtype)
    out = jax.ops.segment_sum(y, row_tok, num_segments=n + 1)[:n]
    return out.reshape(b, s, d)


def setup_inputs(seed: int = 0) -> dict:
    key = jax.random.key(seed)
    ks = iter(jax.random.split(key, 40))
    nrm = lambda shape, sc: jax.random.normal(next(ks), shape, jnp.float32) * sc
    d = D_MODEL
    return {
        "x": nrm((BATCH, SEQ, d), 1.0),
        "c": nrm((BATCH, d), 1.0),
        "rel_bias": nrm((N_BUCKETS, N_BIAS_HEADS), 0.5),
        "l0_norm1": 1.0 + nrm((d,), 0.02),
        "l0_ada_w": nrm((d, 6 * d), 0.5 * d ** -0.5),
        "l0_ada_b": nrm((6 * d,), 0.02),
        "l0_w_in": nrm((d, EVEN_IN), d ** -0.5),
        "l0_fox_fb": 4.0 + nrm((N_FOX_HEADS,), 0.5),
        "l0_w_out": nrm((EVEN_OUT, d), EVEN_OUT ** -0.5),
        "l0_norm2": 1.0 + nrm((d,), 0.02),
        "l0_router_w": nrm((d, N_EXPERTS), d ** -0.5),
        "l0_router_b": nrm((N_EXPERTS,), 0.01),
        "l0_w1": nrm((N_EXPERTS, d, 2 * D_EXPERT), d ** -0.5),
        "l0_b1": nrm((N_EXPERTS, 2 * D_EXPERT), 0.01),
        "l0_w2": nrm((N_EXPERTS, D_EXPERT, d), D_EXPERT ** -0.5),
        "l0_b2": nrm((N_EXPERTS, d), 0.01),
        "l1_norm1": 1.0 + nrm((d,), 0.02),
        "l1_ada_w": nrm((d, 6 * d), 0.5 * d ** -0.5),
        "l1_ada_b": nrm((6 * d,), 0.02),
        "l1_w_in": nrm((d, ODD_IN), d ** -0.5),
        "l1_kv_norm": 1.0 + nrm((KV_RANK,), 0.02),
        "l1_w_ukv": nrm((KV_RANK, 2 * N_DSA_HEADS * HEAD_DIM), KV_RANK ** -0.5),
        "l1_w_out": nrm((ODD_OUT, d), ODD_OUT ** -0.5),
        "l1_norm2": 1.0 + nrm((d,), 0.02),
        "l1_router_w": nrm((d, N_EXPERTS), d ** -0.5),
        "l1_router_b": nrm((N_EXPERTS,), 0.01),
        "l1_w1": nrm((N_EXPERTS, d, 2 * D_EXPERT), d ** -0.5),
        "l1_b1": nrm((N_EXPERTS, 2 * D_EXPERT), 0.01),
        "l1_w2": nrm((N_EXPERTS, D_EXPERT, d), D_EXPERT ** -0.5),
        "l1_b2": nrm((N_EXPERTS, d), 0.01),
        "final_norm": 1.0 + nrm((d,), 0.02),
    }


def reference(x, c, rel_bias,
              l0_norm1, l0_ada_w, l0_ada_b, l0_w_in, l0_fox_fb, l0_w_out,
              l0_norm2, l0_router_w, l0_router_b, l0_w1, l0_b1, l0_w2, l0_b2,
              l1_norm1, l1_ada_w, l1_ada_b, l1_w_in, l1_kv_norm, l1_w_ukv, l1_w_out,
              l1_norm2, l1_router_w, l1_router_b, l1_w1, l1_b1, l1_w2, l1_b2,
              final_norm):
    even_params = (l0_w_in, l0_fox_fb, l0_w_out)
    odd_params = (l1_w_in, l1_kv_norm, l1_w_ukv, l1_w_out)
    common = (
        (l0_norm1, l0_ada_w, l0_ada_b, l0_norm2, l0_router_w, l0_router_b, l0_w1, l0_b1, l0_w2, l0_b2),
        (l1_norm1, l1_ada_w, l1_ada_b, l1_norm2, l1_router_w, l1_router_b, l1_w1, l1_b1, l1_w2, l1_b2),
    )
    for i in range(DEPTH):
        norm1, ada_w, ada_b, norm2, rw, rb, w1, b1, w2, b2 = common[i]
        mods = (jax.nn.silu(c) @ ada_w + ada_b)[:, None, :]
        shift1, scale1, gate1, shift2, scale2, gate2 = jnp.split(mods, 6, axis=-1)
        h = rmsnorm(x, norm1) * (1.0 + scale1) + shift1
        if i % 2 == 0:
            mix = even_mixer(h, *even_params, rel_bias)
        else:
            mix = odd_mixer(h, *odd_params, rel_bias)
        x = x + gate1 * mix
        h = rmsnorm(x, norm2) * (1.0 + scale2) + shift2
        x = x + gate2 * moe_ffn(h, rw, rb, w1, b1, w2, b2)
    return rmsnorm(x, final_norm)
```

```cpp
#define ONE_LAUNCH 1
#define CONV_IN_P11 1
#define CONV_IN_P3 1
#include <hip/hip_runtime.h>
#include <hip/hip_bf16.h>
#include <cmath>
#include <cstdint>
#include <cstdio>

#define LAS __attribute__((address_space(3)))
#define GAS __attribute__((address_space(1)))
typedef unsigned short bf16_t;
typedef short bf16x8 __attribute__((ext_vector_type(8)));
typedef short s16x4 __attribute__((ext_vector_type(4)));
typedef float f32x4 __attribute__((ext_vector_type(4)));
typedef float f32x2 __attribute__((ext_vector_type(2)));
typedef float f32x16 __attribute__((ext_vector_type(16)));
typedef unsigned u32x4 __attribute__((ext_vector_type(4)));
typedef unsigned u32x2 __attribute__((ext_vector_type(2)));

constexpr int NTOK = 32768, DM = 1024, SEQ = 8192, NB = 4;
constexpr int NEXP = 32, TOPK = 4, DEXP = 1024;
constexpr int EVEN_IN = 3848, ODD_IN = 1864;
constexpr int QKV0_LD = 3840, MER_LD = 768;
constexpr int L1N = 5120;
constexpr int ACT_ROWS = NTOK * TOPK + NEXP * 256;
constexpr float EPS = 1e-6f;
constexpr float LOG2E = 1.4426950408889634f;
constexpr float C2 = 0.125f * LOG2E;

constexpr size_t MiB = 1u << 20;
constexpr size_t WS_CTL = 0, CTL_ZERO_BYTES = 1 * MiB;
constexpr size_t WS_MODS = 1 * MiB;
constexpr size_t WS_BT0 = 2 * MiB;
constexpr size_t WS_WO0 = 10 * MiB;
constexpr size_t WS_BT1 = 12 * MiB;
constexpr size_t WS_WC1 = 22 * MiB;
constexpr size_t WS_W1T = 32 * MiB;
constexpr size_t WS_W2T = 160 * MiB;
constexpr size_t WS_H = 224 * MiB;
constexpr size_t WS_LF = 288 * MiB;
constexpr size_t WS_KB2 = 289 * MiB;
constexpr size_t WS_TOK = 290 * MiB;
constexpr size_t WS_SLOT = 294 * MiB;
constexpr size_t WS_GATE = 294 * MiB + 512 * 1024;
constexpr size_t WS_WI = 296 * MiB;
constexpr size_t WS_R1 = 300 * MiB;
constexpr size_t WS_QKV0 = WS_R1, WS_MER = WS_R1 + 240 * MiB;
constexpr size_t WS_ACT = WS_R1, WS_Y = WS_R1 + 272 * MiB;
constexpr size_t WS_QP = WS_R1, WS_CKV = WS_R1 + 256 * MiB, WS_QI = WS_R1 + 272 * MiB, WS_KI = WS_R1 + 304 * MiB, WS_SEL = WS_R1 + 308 * MiB, WS_CKVN = WS_R1 + 324 * MiB, WS_U = WS_R1 + 340 * MiB;
constexpr size_t WS_H8 = WS_R1 + 596 * MiB;
constexpr size_t WS_X16 = WS_H8 + 32 * MiB;
constexpr size_t WS_END = WS_X16 + 64 * MiB;
constexpr int CW_TMO = 0;
constexpr int CW_BAR = 4096;
constexpr int CW_CNT = 16384;

constexpr int RING_BYTES = 131072;
constexpr int MISC_OFF = 160 * 1024 - 256;
constexpr int LDS_BYTES = 160 * 1024;

#define LDS_WAIT() asm volatile("s_waitcnt lgkmcnt(0)" ::: "memory")
#define VM_WAIT() asm volatile("s_waitcnt vmcnt(0)" ::: "memory")

__device__ __forceinline__ unsigned f2bf(float f) { unsigned u = __builtin_bit_cast(unsigned, f); return (u + 0x7fffu + ((u >> 16) & 1u)) >> 16; }
__device__ __forceinline__ unsigned pk2(float lo, float hi) { return f2bf(lo) | (f2bf(hi) << 16); }
__device__ __forceinline__ float bf2f(unsigned short b) { return __builtin_bit_cast(float, (unsigned)b << 16); }
__device__ __forceinline__ unsigned cvt_pk_bf16(float lo, float hi) { unsigned r; asm volatile("v_cvt_pk_bf16_f32 %0, %1, %2" : "=v"(r) : "v"(lo), "v"(hi)); return r; }
__device__ __forceinline__ float wave_sum(float v) {
#pragma unroll
    for (int o = 1; o < 64; o <<= 1) v += __shfl_xor(v, o);
    return v;
}

#define XB_TMO      128
#define XB_XCNT(j)  (256  + 64 * (j))
#define XB_XSUB(j)  (1280 + 64 * (j))
#define XB_XGEN(j)  (2304 + 64 * (j))
#define XB_TOP      3328
#define XB_TOPGEN   3392
#define XCD_BAR_WORDS 3456
#define XB_SPIN_CAP (1u << 18)

__device__ __forceinline__ unsigned xb_ld(unsigned* p)              { return __hip_atomic_load(p, __ATOMIC_RELAXED, __HIP_MEMORY_SCOPE_AGENT); }
__device__ __forceinline__ unsigned xb_add(unsigned* p, unsigned v) { return __hip_atomic_fetch_add(p, v, __ATOMIC_RELAXED, __HIP_MEMORY_SCOPE_AGENT); }
__device__ __forceinline__ unsigned xb_xcc_id() { return (unsigned)__builtin_amdgcn_s_getreg((3 << 11) | 20) & 0xFu; }
#define XB_SPIN(cond, bar) do { unsigned _sp = 0; while (cond) { __builtin_amdgcn_s_sleep(1); \
    if ((++_sp & 255u) == 0u) { if (xb_ld(&(bar)[XB_TMO])) break; if (_sp > XB_SPIN_CAP) { atomicAdd(&(bar)[XB_TMO], 1u); break; } } } } while (0)

struct XcdBarrier { unsigned* bar; unsigned x; volatile LAS unsigned* st; };

__device__ __forceinline__ XcdBarrier xcd_barrier_post(unsigned* bar, volatile LAS unsigned* st, const bool thread0) {
    XcdBarrier b; b.bar = bar; b.x = xb_xcc_id(); b.st = st;
    if (thread0) (void)xb_add(&bar[XB_XCNT(b.x)], 1u);
    return b;
}
__device__ __forceinline__ void xcd_barrier_complete(unsigned* bar, unsigned x, unsigned& nloc, unsigned& nx) {
    const unsigned G = gridDim.x * gridDim.y * gridDim.z;
    unsigned sum, cnt, mine, sp = 0u;
    for (;;) {
        sum = 0u; cnt = 0u; mine = 0u;
#pragma unroll
        for (unsigned j = 0; j < 16; ++j) { const unsigned c = xb_ld(&bar[XB_XCNT(j)]); sum += c; cnt += (c > 0u) ? 1u : 0u; mine = (j == x) ? c : mine; }
        if (sum == G) break;
        __builtin_amdgcn_s_sleep(1);
        if ((++sp & 255u) == 0u) { if (xb_ld(&bar[XB_TMO])) break; if (sp > XB_SPIN_CAP) { atomicAdd(&bar[XB_TMO], 1u); break; } }
    }
    nloc = mine > 0u ? mine : 1u; nx = cnt > 0u ? cnt : 1u;
}
__device__ __forceinline__ void xcd_barrier(const XcdBarrier& b, const bool thread0) {
    asm volatile("s_waitcnt vmcnt(0)" ::: "memory");
    __syncthreads();
    if (thread0) {
        unsigned* bar = b.bar;
        __builtin_amdgcn_s_waitcnt(0);
        unsigned nloc = b.st[0], nx = b.st[1];
        if (nloc == 0u) { xcd_barrier_complete(bar, b.x, nloc, nx); b.st[0] = nloc; b.st[1] = nx; }
        const unsigned old = xb_add(&bar[XB_XSUB(b.x)], 1u);
        const unsigned gen = old / nloc;
        if (old + 1u == (gen + 1u) * nloc) {
            __builtin_amdgcn_fence(__ATOMIC_RELEASE, "agent");
            asm volatile("s_waitcnt vmcnt(0)" ::: "memory");
            const unsigned og = xb_add(&bar[XB_TOP], 1u);
            const unsigned tg = og / nx;
            if (og + 1u == (tg + 1u) * nx) xb_add(&bar[XB_TOPGEN], 1u);
            else XB_SPIN(xb_ld(&bar[XB_TOPGEN]) == tg, bar);
            __builtin_amdgcn_fence(__ATOMIC_ACQUIRE, "agent");
            xb_add(&bar[XB_XGEN(b.x)], 1u);
            asm volatile("s_waitcnt vmcnt(0)" ::: "memory");
        } else {
            XB_SPIN(xb_ld(&bar[XB_XGEN(b.x)]) == gen, bar);
            __builtin_amdgcn_fence(__ATOMIC_ACQUIRE, "agent");
            asm volatile("s_waitcnt vmcnt(0)" ::: "memory");
        }
    }
    __syncthreads();
}

#ifndef PG8_PEEL
#define PG8_PEEL 0
#endif
namespace pg8 {
constexpr int BM = 256, BK = 64, HALF = 128, HTB = HALF * BK * 2, STAGE_BYTES = 8 * HTB;
__host__ __device__ __forceinline__ int lds_byte(int r, int c) { const int st = (r >> 4) * 2 + (c >> 5), rr = r & 15, cc = c & 31, ob = rr * 64 + cc * 2; return st * 1024 + (ob ^ (((ob >> 9) & 1) << 5)); }
__host__ __device__ __forceinline__ void stage_rc(int b, int& R, int& C) { const int st = b / 1024, sb = b % 1024, swz = sb ^ (((sb >> 9) & 1) << 5); R = (st >> 1) * 16 + swz / 64; C = (st & 1) * 32 + (swz % 64) / 2; }
__host__ __device__ __forceinline__ int perm32(int rho) { const int n = rho >> 4, i = rho & 15; return 8 * (i >> 2) + 4 * n + (i & 3); }

struct Unit { int pm, pn, e, aux; };
typedef int i32x8 __attribute__((ext_vector_type(8)));
typedef int i32x4 __attribute__((ext_vector_type(4)));
__device__ __forceinline__ i32x8 cat8(bf16x8 lo, bf16x8 hi) { const i32x4 a = __builtin_bit_cast(i32x4, lo), b = __builtin_bit_cast(i32x4, hi); return __builtin_shufflevector(a, b, 0, 1, 2, 3, 4, 5, 6, 7); }
__device__ __forceinline__ void mfma_f8(f32x4& acc, const i32x8 a, const i32x8 b, const int sc) { asm volatile("v_mfma_scale_f32_16x16x128_f8f6f4 %0, %1, %2, %0, %3, %3 op_sel_hi:[0,0,0]" : "+v"(acc) : "v"(a), "v"(b), "v"(sc)); }
template <class Epi, class Sched, bool ALIGN_EPI, bool FP8 = false>
__device__ __forceinline__ void gemm_phase(LAS unsigned char* lds, const int tid, const bf16_t* Abase, int lda, int K, const Sched& S, const Epi& E) {
    const int wid = __builtin_amdgcn_readfirstlane(tid >> 6), lane = tid & 63, wr = wid >> 2, wc = wid & 3, fr = lane & 15, fq = lane >> 4;
    constexpr int ESZ = FP8 ? 1 : 2;
    const int nt = K * ESZ / 128;
    int R0, C0;
    if (FP8) { const int b_ = tid * 16; R0 = b_ >> 7; C0 = 8 * (((b_ >> 4) & 7) ^ ((R0 >> 1) & 7)); } else stage_rc(tid * 16, R0, C0);
    const int R1 = R0 + 64;
    const int Rb0 = Epi::PERM ? ((R0 & ~31) + perm32(R0 & 31)) : R0;
    unsigned voffB[2]; voffB[0] = (unsigned)(Rb0 * K * ESZ + C0 * 2); voffB[1] = voffB[0] + (unsigned)(64 * K * ESZ);
    const unsigned cA0 = (unsigned)C0 * 2u, cA1 = cA0, lda2 = (unsigned)(lda * ESZ);
    const size_t kstep = (size_t)(BK * 2);
    const unsigned ldsw = (unsigned)wid * 1024u;
    const int sw8 = (fr >> 1) & 7;
    const int aoff = FP8 ? (wr * 64 + fr) * 128 + (((2 * fq) ^ sw8) * 16) : lds_byte(wr * 64 + fr, fq * 8), boff = FP8 ? (wc * 32 + fr) * 128 + (((2 * fq) ^ sw8) * 16) : lds_byte(wc * 32 + fr, fq * 8);
#define PG8_SA(b, h) (((b) * 2 + (h)) * HTB)
#define PG8_SB(b, h) ((4 + (b) * 2 + (h)) * HTB)
#define PG8_STAGE(bufoff, gbase, voff) do { _Pragma("unroll") for (int _i = 0; _i < 2; ++_i) \
        __builtin_amdgcn_global_load_lds((const unsigned*)((const char*)(gbase) + (voff)[_i]), (LAS unsigned*)(lds + (bufoff) + ldsw + _i * 8192), 16, 0, 0); } while (0)
#define PG8_LDA(dst, b, h) do { _Pragma("unroll") for (int m = 0; m < 4; ++m) _Pragma("unroll") for (int k = 0; k < 2; ++k) dst[m][k] = *(const LAS bf16x8*)(lds + PG8_SA(b, h) + (k ? (FP8 ? (aoff ^ 16) : aoff + 1024) : aoff) + m * 2048); } while (0)
#define PG8_LDB(dst, b, h) do { _Pragma("unroll") for (int n = 0; n < 2; ++n) _Pragma("unroll") for (int k = 0; k < 2; ++k) dst[n][k] = *(const LAS bf16x8*)(lds + PG8_SB(b, h) + (k ? (FP8 ? (boff ^ 16) : boff + 1024) : boff) + n * 2048); } while (0)
#define PG8_MMA(ai, bj, At, Bt) do { __builtin_amdgcn_s_setprio(1); _Pragma("unroll") for (int m = 0; m < 4; ++m) _Pragma("unroll") for (int n = 0; n < 2; ++n) { \
        if (FP8) mfma_f8(acc[ai][bj][m][n], cat8(Bt[n][0], Bt[n][1]), cat8(At[m][0], At[m][1]), 0x7f7f7f7f); \
        else { _Pragma("unroll") for (int k = 0; k < 2; ++k) acc[ai][bj][m][n] = __builtin_amdgcn_mfma_f32_16x16x32_bf16(Bt[n][k], At[m][k], acc[ai][bj][m][n], 0, 0, 0); } } __builtin_amdgcn_s_setprio(0); } while (0)
#define PG8_WAIT_V(n) asm volatile("s_waitcnt vmcnt(" #n ")" ::: "memory")
#define PG8_WAIT_L(n) asm volatile("s_waitcnt lgkmcnt(" #n ")" ::: "memory")
#define PG8_BAR __builtin_amdgcn_s_barrier()
#define PG8_SCHED __builtin_amdgcn_sched_barrier(0)
#define PG8_SCHED8 do { if constexpr (FP8) __builtin_amdgcn_sched_barrier(0); } while (0)
#define PG8_OFFS(u, o0, o1) do { o0[0] = (unsigned)S.rowA(u, R0) * lda2 + cA0; o0[1] = (unsigned)S.rowA(u, R1) * lda2 + cA1; \
        o1[0] = (unsigned)S.rowA(u, HALF + R0) * lda2 + cA0; o1[1] = (unsigned)S.rowA(u, HALF + R1) * lda2 + cA1; } while (0)
    Unit cur, nxt; int ui = 0;
    if (!S.next(0, cur)) return;
    LAS float* const BL = (LAS float*)(lds + 131072 + 2048);
    LAS int* const NXT = (LAS int*)(lds + 131072 + 4096);
    f32x4 acc[2][2][4][2];
#pragma unroll
    for (int a = 0; a < 2; ++a)
#pragma unroll
        for (int b = 0; b < 2; ++b)
#pragma unroll
            for (int m = 0; m < 4; ++m)
#pragma unroll
                for (int n = 0; n < 2; ++n) acc[a][b][m][n] = (f32x4){0.f, 0.f, 0.f, 0.f};
    bf16x8 At[4][2], B0[2][2], B1[2][2];
    unsigned oc0[2], oc1[2], on0[2], on1[2];
    PG8_OFFS(cur, oc0, oc1);
    const char* const Ab = (const char*)Abase;
    const char* cB0 = S.bptr(cur, 0); const char* cB1 = S.bptr(cur, 1);
    PG8_STAGE(PG8_SB(0, 0), cB0, voffB); PG8_STAGE(PG8_SB(0, 1), cB1, voffB); PG8_STAGE(PG8_SA(0, 0), Ab, oc0); PG8_STAGE(PG8_SA(0, 1), Ab, oc1);
    if (wr == 1) PG8_BAR;
    PG8_WAIT_V(2); PG8_BAR;
    PG8_STAGE(PG8_SB(1, 0), cB0 + kstep, voffB); PG8_STAGE(PG8_SA(1, 0), Ab + kstep, oc0); PG8_STAGE(PG8_SB(1, 1), cB1 + kstep, voffB);
    PG8_WAIT_V(6); PG8_BAR;
    for (;;) {
        const bool has_next = S.next(ui + 1, nxt);
        const char* nB0 = cB0; const char* nB1 = cB1;
        on0[0] = oc0[0]; on0[1] = oc0[1]; on1[0] = oc1[0]; on1[1] = oc1[1];
        if (has_next) { nB0 = S.bptr(nxt, 0); nB1 = S.bptr(nxt, 1);
            if constexpr (Sched::ROWS_LDS) { int t_ = tid; asm volatile("" : "+v"(t_));
                if (wid < 4) __builtin_amdgcn_global_load_lds((const unsigned*)S.row_ptr(nxt, t_), (LAS unsigned*)(NXT + ((ui + 1) & 1) * 256 + wid * 64), 4, 0, 0); }
            else PG8_OFFS(nxt, on0, on1); }
        if constexpr (Epi::NBIAS > 0) { int t_ = tid; asm volatile("" : "+v"(t_)); if (wid < 4) __builtin_amdgcn_global_load_lds((const unsigned*)E.bias_ptr(cur, t_), (LAS unsigned*)(BL + (ui & 1) * 256 + wid * 64), 4, 0, 0); }
#define PG8_KBODY(A1, A2, B20, B21, O20, O21) do { \
            const char* a3_ = (A2) + kstep; const char* b30_ = (B20) + kstep; const char* b31_ = (B21) + kstep; \
            PG8_LDB(B0, 0, 0); PG8_LDB(B1, 0, 1); PG8_SCHED; PG8_LDA(At, 0, 0); PG8_STAGE(PG8_SA(1, 1), A1, oc1); \
            PG8_WAIT_V(8); PG8_WAIT_L(0); PG8_BAR; PG8_SCHED8; PG8_MMA(0, 0, At, B0); PG8_MMA(0, 1, At, B1); PG8_SCHED8; PG8_BAR; PG8_SCHED; \
            PG8_LDA(At, 0, 1); PG8_STAGE(PG8_SB(0, 0), B20, voffB); PG8_STAGE(PG8_SB(0, 1), B21, voffB); PG8_STAGE(PG8_SA(0, 0), A2, O20); \
            PG8_WAIT_V(8); PG8_WAIT_L(0); PG8_BAR; PG8_SCHED8; PG8_MMA(1, 0, At, B0); PG8_MMA(1, 1, At, B1); PG8_SCHED8; PG8_BAR; PG8_SCHED; \
            PG8_LDB(B0, 1, 0); PG8_LDB(B1, 1, 1); PG8_SCHED; PG8_LDA(At, 1, 0); PG8_STAGE(PG8_SA(0, 1), A2, O21); \
            PG8_WAIT_V(8); PG8_WAIT_L(0); PG8_BAR; PG8_SCHED8; PG8_MMA(0, 0, At, B0); PG8_MMA(0, 1, At, B1); PG8_SCHED8; PG8_BAR; PG8_SCHED; \
            PG8_LDA(At, 1, 1); PG8_STAGE(PG8_SB(1, 0), b30_, voffB); PG8_STAGE(PG8_SB(1, 1), b31_, voffB); PG8_STAGE(PG8_SA(1, 0), a3_, O20); \
            PG8_WAIT_V(8); PG8_WAIT_L(0); PG8_BAR; PG8_SCHED8; PG8_MMA(1, 0, At, B0); PG8_MMA(1, 1, At, B1); PG8_SCHED8; PG8_BAR; PG8_SCHED; } while (0)
#if PG8_PEEL
        for (int t = 0; t < nt - 2; t += 2) {
            const char* a1 = Ab + (size_t)(t + 1) * kstep; const char* a2 = Ab + (size_t)(t + 2) * kstep;
            const char* b20 = cB0 + (size_t)(t + 2) * kstep; const char* b21 = cB1 + (size_t)(t + 2) * kstep;
            PG8_KBODY(a1, a2, b20, b21, oc0, oc1);
        }
        { const char* a1 = Ab + (size_t)(nt - 1) * kstep; PG8_KBODY(a1, Ab, nB0, nB1, on0, on1); }
#else
        unsigned o20[2], o21[2];
#pragma unroll 1
        for (int t = 0; t < nt; t += 2) {
            const bool last = (t == nt - 2);
            const char* a1 = Ab + (size_t)(t + 1) * kstep; const char* a2 = last ? Ab : Ab + (size_t)(t + 2) * kstep;
            const char* b20 = last ? nB0 : cB0 + (size_t)(t + 2) * kstep; const char* b21 = last ? nB1 : cB1 + (size_t)(t + 2) * kstep;
            o20[0] = oc0[0]; o20[1] = oc0[1]; o21[0] = oc1[0]; o21[1] = oc1[1];
            if constexpr (Sched::ROWS_LDS) { if (last && has_next) { const LAS int* nx = NXT + ((ui + 1) & 1) * 256;
                o20[0] = (unsigned)nx[R0] * lda2 + cA0; o20[1] = (unsigned)nx[R1] * lda2 + cA1; o21[0] = (unsigned)nx[HALF + R0] * lda2 + cA0; o21[1] = (unsigned)nx[HALF + R1] * lda2 + cA1; } }
            else { if (last) { o20[0] = on0[0]; o20[1] = on0[1]; o21[0] = on1[0]; o21[1] = on1[1]; } }
            PG8_KBODY(a1, a2, b20, b21, o20, o21);
        }
#endif
#undef PG8_KBODY
        if constexpr (ALIGN_EPI) { if (wr == 0) PG8_BAR; }
        { int fr_ = fr, fq_ = fq; asm volatile("" : "+v"(fr_), "+v"(fq_));
          E(acc, cur, wr, wc, fr_, fq_, BL + (ui & 1) * 256); }
        if (!has_next) break;
#pragma unroll
        for (int a = 0; a < 2; ++a)
#pragma unroll
            for (int b = 0; b < 2; ++b)
#pragma unroll
                for (int m = 0; m < 4; ++m)
#pragma unroll
                    for (int n = 0; n < 2; ++n) acc[a][b][m][n] = (f32x4){0.f, 0.f, 0.f, 0.f};
        cur = nxt; cB0 = nB0; cB1 = nB1; oc0[0] = o20[0]; oc0[1] = o20[1]; oc1[0] = o21[0]; oc1[1] = o21[1]; ++ui;
        if constexpr (ALIGN_EPI) { if (wr == 1) PG8_BAR; }
    }
    PG8_WAIT_V(0);
    if constexpr (!ALIGN_EPI) { if (wr == 0) PG8_BAR; }
    PG8_BAR;
#undef PG8_SA
#undef PG8_SB
#undef PG8_STAGE
#undef PG8_LDA
#undef PG8_LDB
#undef PG8_MMA
#undef PG8_WAIT_V
#undef PG8_WAIT_L
#undef PG8_BAR
#undef PG8_SCHED
#undef PG8_SCHED8
#undef PG8_OFFS
}
}
struct Args { const float* in[31]; float* out; unsigned char* ws; int ph_lo, ph_hi; };
enum { I_X = 0, I_C, I_RELB, I_L0N1, I_L0ADAW, I_L0ADAB, I_L0WIN, I_L0FB, I_L0WOUT, I_L0N2, I_L0RW, I_L0RB, I_L0W1, I_L0B1, I_L0W2, I_L0B2,
       I_L1N1, I_L1ADAW, I_L1ADAB, I_L1WIN, I_L1KVN, I_L1WUKV, I_L1WOUT, I_L1N2, I_L1RW, I_L1RB, I_L1W1, I_L1B1, I_L1W2, I_L1B2, I_FN };

struct Ctx { LAS unsigned char* lds; int tid, lane, wave, G, vcu; };

__device__ __forceinline__ void transpose_item(const float* __restrict__ W, int ldw, int K, int nblk, bf16_t* WT, int row_off, float scale, LAS float* scr, int item, int lane) {
    const int kb = item / nblk, nb = item % nblk, k0 = 64 * kb, n0 = 32 * nb;
#pragma unroll 8
    for (int i = 0; i < 32; ++i) { const int kk = 2 * i + (lane >> 5); scr[kk * 33 + (lane & 31)] = W[(size_t)(k0 + kk) * ldw + n0 + (lane & 31)] * scale; }
    LDS_WAIT(); asm volatile("" ::: "memory");
    const int c = lane & 7;
#pragma unroll
    for (int j = 0; j < 4; ++j) { const int n = (lane >> 3) + 8 * j; const LAS float* s = scr + (8 * c) * 33 + n;
        u32x4 o; o.x = pk2(s[0 * 33], s[1 * 33]); o.y = pk2(s[2 * 33], s[3 * 33]); o.z = pk2(s[4 * 33], s[5 * 33]); o.w = pk2(s[6 * 33], s[7 * 33]);
        *(u32x4*)(WT + (size_t)(row_off + n0 + n) * K + k0 + 8 * c) = o; }
    LDS_WAIT(); asm volatile("" ::: "memory");
}
constexpr float FP8_SW = 64.f, FP8_SH = 8.f, FP8_SA = 4.f, FP8_SQP = 1024.f, FP8_SWC = 128.f, FP8_SU = 16.f, FP8_SY = 32.f, FP8_SQ = 64.f, FP8_SW0 = 256.f;
__device__ __forceinline__ unsigned char to_fp8(float a) { a = __builtin_amdgcn_fmed3f(a, -448.f, 448.f); return (unsigned char)(__builtin_amdgcn_cvt_pk_fp8_f32(a, 0.f, 0, false) & 0xff); }
__device__ __forceinline__ unsigned pk4_fp8(float a, float b, float c, float d) {
    a = __builtin_amdgcn_fmed3f(a, -448.f, 448.f); b = __builtin_amdgcn_fmed3f(b, -448.f, 448.f); c = __builtin_amdgcn_fmed3f(c, -448.f, 448.f); d = __builtin_amdgcn_fmed3f(d, -448.f, 448.f);
    int w = __builtin_amdgcn_cvt_pk_fp8_f32(a, b, 0, false); w = __builtin_amdgcn_cvt_pk_fp8_f32(c, d, w, true); return (unsigned)w; }
__device__ __forceinline__ void transpose_item_fp8(const float* __restrict__ W, int ldw, int K, int nblk, unsigned char* WT, int row_off, float scale, LAS float* scr, int item, int lane) {
    const int kb = item / nblk, nb = item % nblk, k0 = 64 * kb, n0 = 32 * nb;
#pragma unroll 8
    for (int i = 0; i < 32; ++i) { const int kk = 2 * i + (lane >> 5); scr[kk * 33 + (lane & 31)] = W[(size_t)(k0 + kk) * ldw + n0 + (lane & 31)] * scale; }
    LDS_WAIT(); asm volatile("" ::: "memory");
    const int n = lane & 31, kh = (lane >> 5) * 32; const LAS float* sp = scr + kh * 33 + n;
    u32x4 o0, o1;
    o0.x = pk4_fp8(sp[0 * 33], sp[1 * 33], sp[2 * 33], sp[3 * 33]); o0.y = pk4_fp8(sp[4 * 33], sp[5 * 33], sp[6 * 33], sp[7 * 33]); o0.z = pk4_fp8(sp[8 * 33], sp[9 * 33], sp[10 * 33], sp[11 * 33]); o0.w = pk4_fp8(sp[12 * 33], sp[13 * 33], sp[14 * 33], sp[15 * 33]);
    o1.x = pk4_fp8(sp[16 * 33], sp[17 * 33], sp[18 * 33], sp[19 * 33]); o1.y = pk4_fp8(sp[20 * 33], sp[21 * 33], sp[22 * 33], sp[23 * 33]); o1.z = pk4_fp8(sp[24 * 33], sp[25 * 33], sp[26 * 33], sp[27 * 33]); o1.w = pk4_fp8(sp[28 * 33], sp[29 * 33], sp[30 * 33], sp[31 * 33]);
    unsigned char* dst = WT + (size_t)(row_off + n0 + n) * K + k0 + kh;
    *(u32x4*)dst = o0; *(u32x4*)(dst + 16) = o1;
    LDS_WAIT(); asm volatile("" ::: "memory");
}
__device__ __forceinline__ void convert_moe_weights(const Ctx& c, const float* w1, const float* w2, unsigned char* W1T, unsigned char* W2T, LAS float* scr) {
    const int gw = c.vcu * 8 + c.wave, NGW = c.G * 8;
    constexpr int I1 = 16 * 64, I2 = 16 * 32;
    for (int it = gw; it < NEXP * (I1 + I2); it += NGW) {
        if (it < NEXP * I1) { const int e = it / I1, r = it % I1; transpose_item_fp8(w1 + (size_t)e * 1024 * 2048, 2048, 1024, 64, W1T + (size_t)e * 2048 * 1024, 0, FP8_SW, scr, r, c.lane); }
        else { const int q = it - NEXP * I1, e = q / I2, r = q % I2; transpose_item_fp8(w2 + (size_t)e * 1024 * 1024, 1024, 1024, 32, W2T + (size_t)e * 1024 * 1024, 0, FP8_SW, scr, r, c.lane); }
    }
}
__device__ __forceinline__ void convert_moe_item(int it, int lane, const float* w1, const float* w2, unsigned char* W1T, unsigned char* W2T, LAS float* scr) {
    constexpr int I1 = 16 * 64, I2 = 16 * 32;
    if (it < NEXP * I1) { const int e = it / I1, r = it % I1; transpose_item_fp8(w1 + (size_t)e * 1024 * 2048, 2048, 1024, 64, W1T + (size_t)e * 2048 * 1024, 0, FP8_SW, scr, r, lane); }
    else { const int q = it - NEXP * I1, e = q / I2, r = q % I2; transpose_item_fp8(w2 + (size_t)e * 1024 * 1024, 1024, 1024, 32, W2T + (size_t)e * 1024 * 1024, 0, FP8_SW, scr, r, lane); }
}
__device__ __forceinline__ void mods_items(const Ctx& c, const Args& a) {
    LAS float* sl = (LAS float*)(c.lds + 65536);
    LAS float* red = (LAS float*)(c.lds + 65536 + 16384);
    float* MODS = (float*)(a.ws + WS_MODS);
    bool have = false;
    for (int it = blockIdx.x; it < 192; it += c.G) {
        if (!have) { for (int i = c.tid; i < 4096; i += 512) { const float v = a.in[I_C][i]; sl[i] = v / (1.f + __expf(-v)); } have = true; __syncthreads(); }
        const int l = it / 96, cb = it % 96; const float* W = (l ? a.in[I_L1ADAW] : a.in[I_L0ADAW]) + cb * 64 + c.lane;
        float acc[4] = {0.f, 0.f, 0.f, 0.f};
        const int k0 = c.wave * 128;
#pragma unroll 16
        for (int k = 0; k < 128; ++k) { const float w = W[(size_t)(k0 + k) * 6144];
#pragma unroll
            for (int b = 0; b < 4; ++b) acc[b] += sl[b * 1024 + k0 + k] * w; }
#pragma unroll
        for (int b = 0; b < 4; ++b) red[(c.wave * 4 + b) * 64 + c.lane] = acc[b];
        __syncthreads();
        if (c.tid < 256) { const int b = c.tid >> 6, cc = c.tid & 63; float s = 0.f;
#pragma unroll
            for (int w = 0; w < 8; ++w) s += red[(w * 4 + b) * 64 + cc];
            MODS[(size_t)(l * 4 + b) * 6144 + cb * 64 + cc] = s + (l ? a.in[I_L1ADAB] : a.in[I_L0ADAB])[cb * 64 + cc]; }
        __syncthreads();
    }
}
__device__ __forceinline__ void absorb_items(const Ctx& c, const Args& a) {
    const int gw = c.vcu * 8 + c.wave, NGW = c.G * 8;
    const float* __restrict__ wukv = a.in[I_L1WUKV]; const float* __restrict__ win = a.in[I_L1WIN]; const float* __restrict__ wout = a.in[I_L1WOUT];
    unsigned char* BT1 = a.ws + WS_BT1; unsigned char* WC1 = a.ws + WS_WC1;
    for (int it = gw; it < 8192; it += NGW) {
        if (it < 4096) {
            const int h = it >> 8, cb = (it >> 4) & 15, kb = it & 15, k = kb * 64 + c.lane;
            f32x4 bk[16]; const f32x4* src = (const f32x4*)(win + (size_t)k * ODD_IN + h * 64);
#pragma unroll
            for (int i = 0; i < 16; ++i) bk[i] = src[i];
            for (int ci = 0; ci < 16; ++ci) { const int cc = cb * 16 + ci; const f32x4* wr = (const f32x4*)(wukv + (size_t)cc * 2048 + h * 64); float s = 0.f;
#pragma unroll
                for (int i = 0; i < 16; ++i) { const f32x4 w = wr[i]; s += bk[i].x * w.x + bk[i].y * w.y + bk[i].z * w.z + bk[i].w * w.w; }
                BT1[(size_t)(h * 256 + cc) * 1024 + k] = to_fp8(s * (C2 * FP8_SQP)); }
        } else {
            const int q = it - 4096, h = q >> 8, cb = (q >> 6) & 3, nb = q & 63, cc = cb * 64 + c.lane;
            f32x4 wv[16]; const f32x4* src = (const f32x4*)(wukv + (size_t)cc * 2048 + 1024 + h * 64);
#pragma unroll
            for (int i = 0; i < 16; ++i) wv[i] = src[i];
            float acc[16];
#pragma unroll
            for (int n = 0; n < 16; ++n) acc[n] = 0.f;
#pragma unroll
            for (int d = 0; d < 64; ++d) { const float w = wv[d >> 2][d & 3]; const f32x4* o = (const f32x4*)(wout + (size_t)(h * 64 + d) * 1024 + nb * 16);
#pragma unroll
                for (int n4 = 0; n4 < 4; ++n4) { const f32x4 ov = o[n4]; acc[n4 * 4 + 0] += w * ov.x; acc[n4 * 4 + 1] += w * ov.y; acc[n4 * 4 + 2] += w * ov.z; acc[n4 * 4 + 3] += w * ov.w; } }
#pragma unroll
            for (int n = 0; n < 16; ++n) WC1[(size_t)(nb * 16 + n) * 4096 + h * 256 + cc] = to_fp8(acc[n] * FP8_SWC);
        }
    }
}
__device__ __forceinline__ void p0_prologue(const Ctx& c, const Args& a) {
    mods_items(c, a);
    LAS float* scr = (LAS float*)(c.lds + c.wave * 8704);
    const int gw = c.vcu * 8 + c.wave, NGW = c.G * 8;
    unsigned char* BT0 = a.ws + WS_BT0; bf16_t* WO0 = (bf16_t*)(a.ws + WS_WO0); bf16_t* BT1 = (bf16_t*)(a.ws + WS_BT1);
    constexpr int IA = 16 * 48, IB = 16 * 72, IC = 12 * 32, ID = 16 * 26;
    for (int it = gw; it < IA + IB + IC + ID; it += NGW) {
        int r = it;
        if (r < IA) { transpose_item_fp8(a.in[I_L0WIN], EVEN_IN, 1024, 48, BT0, 0, ((r % 48) < 16 ? C2 : 1.f) * FP8_SW0, scr, r, c.lane); continue; } r -= IA;
        if (r < IB) { transpose_item_fp8(a.in[I_L0WIN] + 1544, EVEN_IN, 1024, 72, BT0, 1536, ((r % 72) < 24 ? C2 : 1.f) * FP8_SW0, scr, r, c.lane); continue; } r -= IB;
        if (r < IC) { transpose_item(a.in[I_L0WOUT], 1024, 768, 32, WO0, 0, 1.f, scr, r, c.lane); continue; } r -= IC;
        transpose_item(a.in[I_L1WIN] + 1024, ODD_IN, 1024, 26, BT1, 4096, 1.f, scr, r, c.lane);
    }
    absorb_items(c, a);
#ifndef CONV_IN_P3
    convert_moe_weights(c, a.in[I_L0W1], a.in[I_L0W2], a.ws + WS_W1T, a.ws + WS_W2T, scr);
#endif
}

__device__ __forceinline__ float reduce8(float (&v)[8], int lane) {
#pragma unroll
    for (int i = 0; i < 4; ++i) { const float send = (lane & 32) ? v[i] : v[i + 4], keep = (lane & 32) ? v[i + 4] : v[i]; v[i] = keep + __shfl_xor(send, 32); }
#pragma unroll
    for (int i = 0; i < 2; ++i) { const float send = (lane & 16) ? v[i] : v[i + 2], keep = (lane & 16) ? v[i + 2] : v[i]; v[i] = keep + __shfl_xor(send, 16); }
    { const float send = (lane & 8) ? v[0] : v[1], keep = (lane & 8) ? v[1] : v[0]; v[0] = keep + __shfl_xor(send, 8); }
    v[0] += __shfl_xor(v[0], 4); v[0] += __shfl_xor(v[0], 2); v[0] += __shfl_xor(v[0], 1);
    return v[0];
}
__device__ __forceinline__ float dot4(f32x4 a, f32x4 b) { return (a.x * b.x + a.y * b.y) + (a.z * b.z + a.w * b.w); }

struct ThinArgs {
    const float* src;
    float* xdst;
    const float* nw;
    const float* mods;
    int sh_off;
    const float* cmods;
    bf16_t* hdst;
    unsigned char* h8dst;
    float* fdst;
    const float* w8; int w8ld;
    const float* fb;
    float* e8dst;
    const float* rw; const float* rb;
    int layer;
    const unsigned char* Y;
    size_t dbg_off;
};
#ifndef TH_R
#define TH_R 4
#endif
constexpr int TH_RB = 131072;
template <bool COMBINE, int EXTRA, bool ROUTER, bool FINAL, bool COPYX, bool XIN16 = false, bool XOUT16 = false>
__device__ __forceinline__ void thin_pass(const Ctx& c, const Args& a, const ThinArgs& t) {
    const int lane = c.lane, wave = c.wave;
    unsigned* ctl = (unsigned*)(a.ws + WS_CTL);
    int* TOK = (int*)(a.ws + WS_TOK + (ROUTER ? t.dbg_off : 0)); unsigned* SLOT = (unsigned*)(a.ws + WS_SLOT + (ROUTER ? t.dbg_off : 0)); float* GATE = (float*)(a.ws + WS_GATE + (ROUTER ? t.dbg_off : 0));
    LAS float* W8 = (LAS float*)c.lds;
    LAS float* RW = (LAS float*)c.lds;
    LAS float* LG = (LAS float*)(c.lds + TH_RB) + wave * 128;
    LAS int* SELE = (LAS int*)(c.lds + TH_RB + 4096);
    LAS int* SELP = (LAS int*)(c.lds + TH_RB + 4096 + 2048);
    LAS int* LCNT = (LAS int*)(c.lds + TH_RB + 8192);
    LAS int* RBASE = (LAS int*)(c.lds + TH_RB + 8192 + 512);
    if (EXTRA) { for (int i = c.tid; i < 8192; i += 512) { const int col = i >> 10, k = i & 1023; W8[i] = t.w8[(size_t)k * t.w8ld + col]; } }
    if (ROUTER) { for (int i = c.tid; i < 8192; i += 512) { const int k = i >> 3, e4 = (i & 7) * 4; const f32x4 w = *(const f32x4*)(t.rw + (size_t)k * 32 + e4);
            RW[(e4 + 0) * 1024 + k] = w.x; RW[(e4 + 1) * 1024 + k] = w.y; RW[(e4 + 2) * 1024 + k] = w.z; RW[(e4 + 3) * 1024 + k] = w.w; } }
    if (COMBINE) { if (wave == 0) { int cn = (lane < 32) ? (int)ctl[CW_CNT + (t.layer * 32 + lane) * 16] : 0; int tl = (cn + 255) >> 8; int inc = tl;
#pragma unroll
            for (int o = 1; o < 32; o <<= 1) { const int v = __shfl_up(inc, o); if (lane >= o) inc += v; }
            if (lane < 32) RBASE[lane] = (inc - tl) * 256; } }
    __syncthreads();
#pragma unroll 1
    for (int rb = blockIdx.x; rb < NTOK / 128; rb += c.G) {
        const int row0 = rb * 128 + wave * 16, b = row0 / SEQ;
#define TH_LOAD_MODS() do { _Pragma("unroll") for (int j = 0; j < 4; ++j) { \
            const f32x4 nwv = *((const f32x4*)t.nw + lane + 64 * j); \
            if (FINAL) { Am[j] = nwv; Bm[j] = (f32x4){0.f, 0.f, 0.f, 0.f}; } \
            else { const f32x4 sc = *((const f32x4*)(t.mods + (size_t)b * 6144 + t.sh_off + 1024) + lane + 64 * j); Bm[j] = *((const f32x4*)(t.mods + (size_t)b * 6144 + t.sh_off) + lane + 64 * j); Am[j] = nwv * (sc + 1.0f); } \
            if (COMBINE) G2[j] = *((const f32x4*)(t.cmods + (size_t)b * 6144 + 5120) + lane + 64 * j); } } while (0)
        f32x4 Am[4], Bm[4], G2[4];
        if (!ROUTER) TH_LOAD_MODS();
        if (ROUTER) { if (c.tid < 32) LCNT[c.tid] = 0; __syncthreads(); }
        constexpr int R = ROUTER ? TH_R : 2;
#pragma unroll 1
        for (int rg = 0; rg < 16; rg += R) {
            if (ROUTER) { asm volatile("" ::: "memory"); TH_LOAD_MODS(); }
            f32x4 h[R][4];
            f32x4 vv[R][4]; unsigned yy[COMBINE ? R : 1][4][4]; float gg[COMBINE ? R : 1][4];
#pragma unroll
            for (int r = 0; r < R; ++r) { const int row = row0 + rg + r;
                if (XIN16) { const u32x2* xr = (const u32x2*)((const bf16_t*)t.src + (size_t)row * DM) + lane;
#pragma unroll
                    for (int j = 0; j < 4; ++j) { const u32x2 w = xr[64 * j]; vv[r][j] = (f32x4){__builtin_bit_cast(float, w.x << 16), __builtin_bit_cast(float, w.x & 0xffff0000u), __builtin_bit_cast(float, w.y << 16), __builtin_bit_cast(float, w.y & 0xffff0000u)}; } }
                else { const f32x4* xr = (const f32x4*)(t.src + (size_t)row * DM) + lane;
#pragma unroll
                    for (int j = 0; j < 4; ++j) vv[r][j] = xr[64 * j]; } }
            if (COMBINE) {
#pragma unroll
                for (int r = 0; r < R; ++r) { const int row = row0 + rg + r;
#pragma unroll
                    for (int k = 0; k < 4; ++k) { const unsigned info = SLOT[row * 4 + k]; gg[r][k] = GATE[row * 4 + k]; const int yrow = RBASE[info >> 24] + (int)(info & 0xffffffu);
                        const unsigned* yr = (const unsigned*)(t.Y + (size_t)yrow * DEXP) + lane;
#pragma unroll
                        for (int j = 0; j < 4; ++j) yy[r][k][j] = yr[64 * j]; } }
            }
#pragma unroll
            for (int r = 0; r < R; ++r) {
                const int row = row0 + rg + r;
                f32x4 v[4];
#pragma unroll
                for (int j = 0; j < 4; ++j) v[j] = vv[r][j];
                if (COMBINE) {
#pragma unroll
                    for (int k = 0; k < 4; ++k) { const float g = gg[r][k] * (1.0f / FP8_SY);
#pragma unroll
                        for (int j = 0; j < 4; ++j) { const int y = (int)yy[r][k][j]; const f32x2 lo = __builtin_amdgcn_cvt_pk_f32_fp8(y, false), hi2 = __builtin_amdgcn_cvt_pk_f32_fp8(y, true); const f32x4 yf = {lo.x, lo.y, hi2.x, hi2.y};
                            v[j] += G2[j] * (yf * g); } }
                }
                if ((COMBINE || COPYX) && !FINAL) {
                    if (XOUT16) { u32x2* xo = (u32x2*)((bf16_t*)t.xdst + (size_t)row * DM) + lane;
#pragma unroll
                        for (int j = 0; j < 4; ++j) { u32x2 w; w.x = pk2(v[j].x, v[j].y); w.y = pk2(v[j].z, v[j].w); xo[64 * j] = w;
                            v[j] = (f32x4){__builtin_bit_cast(float, w.x << 16), __builtin_bit_cast(float, w.x & 0xffff0000u), __builtin_bit_cast(float, w.y << 16), __builtin_bit_cast(float, w.y & 0xffff0000u)}; } }
                    else { f32x4* xo = (f32x4*)(t.xdst + (size_t)row * DM) + lane;
#pragma unroll
                        for (int j = 0; j < 4; ++j) xo[64 * j] = v[j]; } }
                f32x2 ss2 = {0.f, 0.f};
#pragma unroll
                for (int j = 0; j < 4; ++j) { ss2 = __builtin_elementwise_fma((f32x2){v[j].x, v[j].y}, (f32x2){v[j].x, v[j].y}, ss2); ss2 = __builtin_elementwise_fma((f32x2){v[j].z, v[j].w}, (f32x2){v[j].z, v[j].w}, ss2); }
                const float ss = ss2.x + ss2.y;
                const float rs = 1.0f / sqrtf(wave_sum(ss) * (1.0f / DM) + EPS);
#pragma unroll
                for (int j = 0; j < 4; ++j) h[r][j] = (v[j] * rs) * Am[j] + Bm[j];
                if (FINAL) { f32x4* o = (f32x4*)(t.fdst + (size_t)row * DM) + lane;
#pragma unroll
                    for (int j = 0; j < 4; ++j) o[64 * j] = h[r][j]; }
                else if (ROUTER || EXTRA == 1) { unsigned* o = (unsigned*)((unsigned char*)t.hdst + (size_t)row * DM) + lane;
#pragma unroll
                    for (int j = 0; j < 4; ++j) o[64 * j] = pk4_fp8(h[r][j].x * FP8_SH, h[r][j].y * FP8_SH, h[r][j].z * FP8_SH, h[r][j].w * FP8_SH); }
                else { u32x2* o = (u32x2*)(t.hdst + (size_t)row * DM) + lane;
#pragma unroll
                    for (int j = 0; j < 4; ++j) { u32x2 w; w.x = pk2(h[r][j].x, h[r][j].y); w.y = pk2(h[r][j].z, h[r][j].w); o[64 * j] = w; }
                    if (EXTRA == 2) { unsigned* o8 = (unsigned*)(t.h8dst + (size_t)row * DM) + lane;
#pragma unroll
                        for (int j = 0; j < 4; ++j) o8[64 * j] = pk4_fp8(h[r][j].x * FP8_SH, h[r][j].y * FP8_SH, h[r][j].z * FP8_SH, h[r][j].w * FP8_SH); } }
                if (EXTRA) {
                    float acc[8];
#pragma unroll
                    for (int cc = 0; cc < 8; ++cc) { f32x2 s2 = {0.f, 0.f};
#pragma unroll
                        for (int j = 0; j < 4; ++j) { const f32x4 w = *((const LAS f32x4*)(W8 + cc * 1024) + lane + 64 * j); s2 = __builtin_elementwise_fma((f32x2){h[r][j].x, h[r][j].y}, (f32x2){w.x, w.y}, s2); s2 = __builtin_elementwise_fma((f32x2){h[r][j].z, h[r][j].w}, (f32x2){w.z, w.w}, s2); }
                        acc[cc] = s2.x + s2.y; if (cc & 1) __builtin_amdgcn_sched_barrier(0); }
                    const float tot = reduce8(acc, lane); const int col = lane >> 3;
                    if ((lane & 7) == 0) {
                        if (EXTRA == 1) { const float z = tot + t.fb[col]; const float lf = fminf(z, 0.f) - log1pf(__expf(-fabsf(z))); t.e8dst[(size_t)(b * 8 + col) * SEQ + (row - b * SEQ)] = lf; }
                        else t.e8dst[(size_t)row * 8 + col] = tot;
                    }
                }
            }
            if (ROUTER) {
#pragma unroll 1
                for (int ec = 0; ec < 4; ++ec) {
                    float acc[R][8]; f32x2 acc2[R][8];
#pragma unroll
                    for (int r = 0; r < R; ++r)
#pragma unroll
                        for (int e = 0; e < 8; ++e) acc2[r][e] = (f32x2){0.f, 0.f};
#pragma unroll
                    for (int e = 0; e < 8; ++e)
#pragma unroll
                        for (int j = 0; j < 4; ++j) { const f32x4 w = *((const LAS f32x4*)(RW + (ec * 8 + e) * 1024) + lane + 64 * j); const f32x2 wl = {w.x, w.y}, wh = {w.z, w.w};
#pragma unroll
                            for (int r = 0; r < R; ++r) { const f32x2 hl = {h[r][j].x, h[r][j].y}, hh = {h[r][j].z, h[r][j].w}; acc2[r][e] = __builtin_elementwise_fma(hl, wl, acc2[r][e]); acc2[r][e] = __builtin_elementwise_fma(hh, wh, acc2[r][e]); }
                            if (j == 3 && (e & 1)) __builtin_amdgcn_sched_barrier(0); }
#pragma unroll
                    for (int r = 0; r < R; ++r)
#pragma unroll
                        for (int e = 0; e < 8; ++e) acc[r][e] = acc2[r][e].x + acc2[r][e].y;
#pragma unroll
                    for (int r = 0; r < R; ++r) { const float tot = reduce8(acc[r], lane); if ((lane & 7) == 0) LG[r * 32 + ec * 8 + (lane >> 3)] = tot + t.rb[ec * 8 + (lane >> 3)]; }
                }
                LDS_WAIT(); asm volatile("" ::: "memory");
                {
                    const int r = lane >> 4, sub = lane & 15;
                    float v0 = LG[r * 32 + sub], v1 = LG[r * 32 + 16 + sub];
                    float tv[4]; int ti[4];
#pragma unroll
                    for (int k = 0; k < 4; ++k) {
                        const bool s1 = v1 > v0; float bv = s1 ? v1 : v0; int bi = s1 ? sub + 16 : sub;
#pragma unroll
                        for (int o = 1; o < 16; o <<= 1) { const float ov = __shfl_xor(bv, o); const int oi = __shfl_xor(bi, o); const bool take = (ov > bv) | ((ov == bv) & (oi < bi)); bv = take ? ov : bv; bi = take ? oi : bi; }
                        tv[k] = bv; ti[k] = bi; v0 = (bi == sub) ? -INFINITY : v0; v1 = (bi == sub + 16) ? -INFINITY : v1;
                    }
                    if (sub == 0 && r < R) {
                        const float e1 = __expf(tv[1] - tv[0]), e2 = __expf(tv[2] - tv[0]), e3 = __expf(tv[3] - tv[0]); const float inv = 1.0f / (1.0f + e1 + e2 + e3);
                        const float gk[4] = {inv, e1 * inv, e2 * inv, e3 * inv};
                        const int rl = wave * 16 + rg + r, row = row0 + rg + r;
#pragma unroll
                        for (int k = 0; k < 4; ++k) { const int p = __hip_atomic_fetch_add((LAS int*)&LCNT[ti[k]], 1, __ATOMIC_RELAXED, __HIP_MEMORY_SCOPE_WORKGROUP); SELE[rl * 4 + k] = ti[k]; SELP[rl * 4 + k] = p; GATE[row * 4 + k] = gk[k]; }
                    }
                }
                asm volatile("" ::: "memory");
            }
        }
        if (ROUTER) {
            __syncthreads();
            if (c.tid < 32) LCNT[32 + c.tid] = (int)__hip_atomic_fetch_add(ctl + CW_CNT + (t.layer * 32 + c.tid) * 16, (unsigned)LCNT[c.tid], __ATOMIC_RELAXED, __HIP_MEMORY_SCOPE_AGENT);
            __syncthreads();
            { const int rl = c.tid >> 2, k = c.tid & 3, e = SELE[rl * 4 + k], p = LCNT[32 + e] + SELP[rl * 4 + k], row = rb * 128 + rl;
              TOK[(size_t)e * NTOK + p] = row; SLOT[row * 4 + k] = ((unsigned)e << 24) | (unsigned)p; }
            __syncthreads();
        }
    }
}
struct DenseSched {
    static constexpr bool ROWS_LDS = false;
    const char* Bt; int K, nN, nU, G, vcu;
    __device__ __forceinline__ bool next(int i, pg8::Unit& u) const { const int L = i * G + vcu; if (L >= nU) return false; u.pm = L / nN; u.pn = L % nN; u.e = 0; u.aux = 256; return true; }
    __device__ __forceinline__ int rowA(const pg8::Unit& u, int r) const { return u.pm * 256 + r; }
    __device__ __forceinline__ const char* bptr(const pg8::Unit& u, int half) const { return Bt + (size_t)(u.pn * 256 + half * 128) * K * 2; }
};
constexpr int MOE_TS = 131072 + 1024;
__device__ __forceinline__ void moe_tables(const Ctx& c, const unsigned* ctl, int layer) {
    LAS int* TS = (LAS int*)(c.lds + MOE_TS); LAS int* CN = TS + 64;
    if (c.wave == 0) { const int cn = (c.lane < 32) ? (int)ctl[CW_CNT + (layer * 32 + c.lane) * 16] : 0; const int tl = (cn + 255) >> 8; int inc = tl;
#pragma unroll
        for (int o = 1; o < 32; o <<= 1) { const int v = __shfl_up(inc, o); if (c.lane >= o) inc += v; }
        if (c.lane < 32) { TS[c.lane + 1] = inc; CN[c.lane] = cn; } if (c.lane == 0) TS[0] = 0; }
    __syncthreads();
}
template <int NTN, bool GATHER>
struct MoeSched {
    static constexpr bool ROWS_LDS = GATHER;
    const LAS int* TS; const LAS int* CN; const int* TOK; const char* W; int G, vcu, total;
    __device__ __forceinline__ const int* row_ptr(const pg8::Unit& u, int r) const { return TOK + (size_t)u.e * NTOK + (u.aux >> 9) + min(r, u.aux & 511); }
    __device__ __forceinline__ bool next(int i, pg8::Unit& u) const {
        const int L = i * G + vcu;
        if (L >= total * NTN) return false;
        const int mt = L / NTN; int e = 0;
#pragma unroll
        for (int j = 1; j < 32; ++j) e += (mt >= TS[j]) ? 1 : 0;
        e = __builtin_amdgcn_readfirstlane(e);
        u.pm = mt; u.pn = L % NTN; u.e = e; const int r0 = (mt - __builtin_amdgcn_readfirstlane(TS[e])) * 256; u.aux = (r0 << 9) | (min(__builtin_amdgcn_readfirstlane(CN[e]) - r0, 256) - 1);
        return true;
    }
    __device__ __forceinline__ int rowA(const pg8::Unit& u, int r) const {
        if (GATHER) { const int p = (u.aux >> 9) + min(r, u.aux & 511); return TOK[(size_t)u.e * NTOK + p]; }
        return u.pm * 256 + r;
    }
    __device__ __forceinline__ const char* bptr(const pg8::Unit& u, int half) const {
        if (GATHER) return W + ((size_t)u.e * 2048 + half * 1024 + u.pn * 128) * 1024;
        return W + ((size_t)u.e * 1024 + u.pn * 256 + half * 128) * 1024;
    }
};
struct EpiBf16Plain {
    static constexpr bool PERM = true; static constexpr int NBIAS = 0; bf16_t* O; int ld; float sc;
    __device__ __forceinline__ void operator()(const f32x4 (&acc)[2][2][4][2], const pg8::Unit& u, int wr, int wc, int fr, int fq, const LAS float*) const {
#pragma unroll
        for (int ai = 0; ai < 2; ++ai)
#pragma unroll
            for (int m = 0; m < 4; ++m) { bf16_t* rowp = O + (size_t)(u.pm * 256 + ai * 128 + wr * 64 + m * 16 + fr) * ld + u.pn * 256 + wc * 32 + 8 * fq;
#pragma unroll
                for (int bj = 0; bj < 2; ++bj) { const f32x4 v0 = acc[ai][bj][m][0] * sc, v1 = acc[ai][bj][m][1] * sc; u32x4 w; w.x = cvt_pk_bf16(v0[0], v0[1]); w.y = cvt_pk_bf16(v0[2], v0[3]); w.z = cvt_pk_bf16(v1[0], v1[1]); w.w = cvt_pk_bf16(v1[2], v1[3]);
                    *(u32x4*)(rowp + bj * 128) = w; } }
    }
};
__device__ __forceinline__ unsigned pk_f16(float a, float b) { const _Float16 x = (_Float16)a, y = (_Float16)b; return (unsigned)__builtin_bit_cast(unsigned short, x) | ((unsigned)__builtin_bit_cast(unsigned short, y) << 16); }
struct EpiFp8Plain {
    static constexpr bool PERM = true; static constexpr int NBIAS = 0; unsigned char* O; int ld; float sc;
    __device__ __forceinline__ void operator()(const f32x4 (&acc)[2][2][4][2], const pg8::Unit& u, int wr, int wc, int fr, int fq, const LAS float*) const {
#pragma unroll
        for (int ai = 0; ai < 2; ++ai)
#pragma unroll
            for (int m = 0; m < 4; ++m) { unsigned char* rowp = O + (size_t)(u.pm * 256 + ai * 128 + wr * 64 + m * 16 + fr) * ld + u.pn * 256 + wc * 32 + 8 * fq;
#pragma unroll
                for (int bj = 0; bj < 2; ++bj) { const f32x4 v0 = acc[ai][bj][m][0] * sc, v1 = acc[ai][bj][m][1] * sc; u32x2 w; w.x = pk4_fp8(v0[0], v0[1], v0[2], v0[3]); w.y = pk4_fp8(v1[0], v1[1], v1[2], v1[3]);
                    *(u32x2*)(rowp + bj * 128) = w; } }
    }
};
struct EpiL1Proj {
    static constexpr bool PERM = true; static constexpr int NBIAS = 0; bf16_t* QP; bf16_t* CKV; bf16_t* QI; bf16_t* KI;
    __device__ __forceinline__ void operator()(const f32x4 (&acc)[2][2][4][2], const pg8::Unit& u, int wr, int wc, int fr, int fq, const LAS float*) const {
        bf16_t* base; int ld, c0; bool f16 = false; int lim = 256;
        if (u.pn == 0) { base = CKV; ld = 256; c0 = 0; } else if (u.pn < 3) { base = QI; ld = 512; c0 = (u.pn - 1) * 256; f16 = true; } else { base = KI; ld = 64; c0 = 0; f16 = true; lim = 64; }
#pragma unroll
        for (int ai = 0; ai < 2; ++ai)
#pragma unroll
            for (int m = 0; m < 4; ++m) { bf16_t* rowp = base + (size_t)(u.pm * 256 + ai * 128 + wr * 64 + m * 16 + fr) * ld + c0;
#pragma unroll
                for (int bj = 0; bj < 2; ++bj) { const int col = bj * 128 + wc * 32 + 8 * fq; const f32x4 v0 = acc[ai][bj][m][0], v1 = acc[ai][bj][m][1]; u32x4 w;
                    if (f16) { w.x = pk_f16(v0[0], v0[1]); w.y = pk_f16(v0[2], v0[3]); w.z = pk_f16(v1[0], v1[1]); w.w = pk_f16(v1[2], v1[3]); }
                    else { w.x = cvt_pk_bf16(v0[0], v0[1]); w.y = cvt_pk_bf16(v0[2], v0[3]); w.z = cvt_pk_bf16(v1[0], v1[1]); w.w = cvt_pk_bf16(v1[2], v1[3]); }
                    if (u.pn == 3) { if (col < 64) { const int row = u.pm * 256 + ai * 128 + wr * 64 + m * 16 + fr; *(u32x4*)(KI + (size_t)(row >> 6) * 4096 + (col >> 3) * 512 + (row & 63) * 8) = w; } }
                    else if (col < lim) *(u32x4*)(rowp + col) = w; } }
    }
};
template <bool XS16, bool XO16>
struct EpiResid {
    static constexpr bool PERM = false; static constexpr int NBIAS = 0; const void* Xs; void* X; const float* gate; float sc;
    __device__ __forceinline__ void operator()(const f32x4 (&acc)[2][2][4][2], const pg8::Unit& u, int wr, int wc, int fr, int fq, const LAS float*) const {
        const int b = (u.pm * 256) / SEQ; const int col0 = u.pn * 256 + wc * 32 + 4 * fq;
        f32x4 gv[2][2];
#pragma unroll
        for (int bj = 0; bj < 2; ++bj)
#pragma unroll
            for (int n = 0; n < 2; ++n) gv[bj][n] = *(const f32x4*)(gate + (size_t)b * 6144 + col0 + bj * 128 + n * 16) * sc;
#pragma unroll
        for (int ai = 0; ai < 2; ++ai)
#pragma unroll
            for (int m = 0; m < 4; ++m) { const size_t off = (size_t)(u.pm * 256 + ai * 128 + wr * 64 + m * 16 + fr) * DM + col0;
#pragma unroll
                for (int bj = 0; bj < 2; ++bj)
#pragma unroll
                    for (int n = 0; n < 2; ++n) { const size_t o_ = off + bj * 128 + n * 16; f32x4 xs;
                        if (XS16) { const u32x2 w = *(const u32x2*)((const bf16_t*)Xs + o_); xs = (f32x4){__builtin_bit_cast(float, w.x << 16), __builtin_bit_cast(float, w.x & 0xffff0000u), __builtin_bit_cast(float, w.y << 16), __builtin_bit_cast(float, w.y & 0xffff0000u)}; }
                        else xs = *(const f32x4*)((const float*)Xs + o_);
                        const f32x4 r_ = xs + gv[bj][n] * acc[ai][bj][m][n];
                        if (XO16) { u32x2 w; w.x = pk2(r_.x, r_.y); w.y = pk2(r_.z, r_.w); *(u32x2*)((bf16_t*)X + o_) = w; } else *(f32x4*)((float*)X + o_) = r_; }
                if (m & 1) asm volatile("" ::: "memory"); }
    }
};
struct EpiSwiglu {
    static constexpr bool PERM = true; static constexpr int NBIAS = 256; unsigned char* ACT; const float* b1;
    __device__ __forceinline__ const float* bias_ptr(const pg8::Unit& u, int i) const { return b1 + (size_t)u.e * 2048 + (i >> 7) * 1024 + u.pn * 128 + (i & 127); }
    __device__ __forceinline__ void operator()(const f32x4 (&acc)[2][2][4][2], const pg8::Unit& u, int wr, int wc, int fr, int fq, const LAS float* bl_) const {
        const int col = u.pn * 128 + wc * 32 + 8 * fq; const LAS float* bp = bl_ + wc * 32 + 8 * fq;
        const f32x4 bg0 = *(const LAS f32x4*)bp, bg1 = *(const LAS f32x4*)(bp + 4), bl0 = *(const LAS f32x4*)(bp + 128), bl1 = *(const LAS f32x4*)(bp + 132);
        constexpr float S1 = 1.0f / (FP8_SH * FP8_SW);
#pragma unroll
        for (int ai = 0; ai < 2; ++ai)
#pragma unroll
            for (int m = 0; m < 4; ++m) { f32x2 o2[4];
#pragma unroll
                for (int n = 0; n < 2; ++n)
#pragma unroll
                    for (int i2 = 0; i2 < 2; ++i2) { const f32x4 ag = acc[ai][0][m][n], al = acc[ai][1][m][n]; const f32x4 bgv = n ? bg1 : bg0, blv = n ? bl1 : bl0;
                        f32x2 g = (f32x2){ag[2 * i2], ag[2 * i2 + 1]} * S1 + (f32x2){bgv[2 * i2], bgv[2 * i2 + 1]};
                        f32x2 l = (f32x2){al[2 * i2], al[2 * i2 + 1]} * S1 + (f32x2){blv[2 * i2], blv[2 * i2 + 1]};
                        g.x = fminf(g.x, 7.0f); g.y = fminf(g.y, 7.0f); l.x = __builtin_amdgcn_fmed3f(l.x, -7.0f, 7.0f); l.y = __builtin_amdgcn_fmed3f(l.y, -7.0f, 7.0f);
                        f32x2 z = g * (-1.702f * LOG2E); z.x = __builtin_amdgcn_exp2f(z.x); z.y = __builtin_amdgcn_exp2f(z.y); z = z + 1.0f; z.x = __builtin_amdgcn_rcpf(z.x); z.y = __builtin_amdgcn_rcpf(z.y);
                        o2[n * 2 + i2] = (g * z) * (l * FP8_SA + FP8_SA); }
                u32x2 w; w.x = pk4_fp8(o2[0].x, o2[0].y, o2[1].x, o2[1].y); w.y = pk4_fp8(o2[2].x, o2[2].y, o2[3].x, o2[3].y);
                *(u32x2*)(ACT + (size_t)(u.pm * 256 + ai * 128 + wr * 64 + m * 16 + fr) * DEXP + col) = w; }
    }
};
struct EpiBiasBf16 {
    static constexpr bool PERM = true; static constexpr int NBIAS = 256; unsigned char* Y; const float* b2;
    __device__ __forceinline__ const float* bias_ptr(const pg8::Unit& u, int i) const { return b2 + (size_t)u.e * 1024 + u.pn * 256 + i; }
    __device__ __forceinline__ void operator()(const f32x4 (&acc)[2][2][4][2], const pg8::Unit& u, int wr, int wc, int fr, int fq, const LAS float* bl_) const {
        const int col0 = u.pn * 256 + wc * 32 + 8 * fq; const LAS float* bp = bl_ + wc * 32 + 8 * fq;
        f32x4 bv[2][2];
#pragma unroll
        for (int bj = 0; bj < 2; ++bj)
#pragma unroll
            for (int n = 0; n < 2; ++n) bv[bj][n] = *(const LAS f32x4*)(bp + bj * 128 + 4 * n);
#pragma unroll
        for (int ai = 0; ai < 2; ++ai)
#pragma unroll
            for (int m = 0; m < 4; ++m) { unsigned char* rowp = Y + (size_t)(u.pm * 256 + ai * 128 + wr * 64 + m * 16 + fr) * DEXP + col0;
#pragma unroll
                for (int bj = 0; bj < 2; ++bj) { const f32x4 v0 = (acc[ai][bj][m][0] * (1.0f / (FP8_SA * FP8_SW)) + bv[bj][0]) * FP8_SY, v1 = (acc[ai][bj][m][1] * (1.0f / (FP8_SA * FP8_SW)) + bv[bj][1]) * FP8_SY; u32x2 w; w.x = pk4_fp8(v0[0], v0[1], v0[2], v0[3]); w.y = pk4_fp8(v1[0], v1[1], v1[2], v1[3]);
                    *(u32x2*)(rowp + bj * 128) = w; } }
    }
};

struct EpiNone { static constexpr bool PERM = true; static constexpr int NBIAS = 0;
    __device__ __forceinline__ void operator()(const f32x4 (&acc)[2][2][4][2], const pg8::Unit& u, int wr, int wc, int fr, int fq, const LAS float*) const { asm volatile("" :: "v"(acc[0][0][0][0]), "v"(acc[1][1][3][1])); } };
namespace att {
__device__ __forceinline__ int crow(int r, int hi) { return (r & 3) + 8 * (r >> 2) + 4 * hi; }
__device__ __forceinline__ void glds16(const void* gsrc, unsigned lds_dst) { unsigned keep;
    asm volatile("s_mov_b32 %0, m0\n\ts_mov_b32 m0, %2\n\ts_nop 0\n\tglobal_load_lds_dwordx4 %1, off\n\ts_mov_b32 m0, %0" : "=&s"(keep) : "v"(gsrc), "s"(lds_dst) : "memory"); }
__device__ __forceinline__ unsigned cvtpk(float lo, float hi) { typedef __bf16 bf2 __attribute__((ext_vector_type(2))); f32x2 v = {lo, hi}; bf2 b = __builtin_convertvector(v, bf2); return __builtin_bit_cast(unsigned, b); }
__device__ __forceinline__ int kimg(int r, int g) { return r * 128 + ((g ^ ((r >> 1) & 7)) * 16); }
__device__ __forceinline__ void qkt(f32x16& p0, f32x16& p1, const LAS unsigned char* Kslot, const bf16x8* qr, int r32, int hi) {
    p0 = f32x16{}; p1 = f32x16{};
#pragma unroll
    for (int d0 = 0; d0 < 4; ++d0) {
        const bf16x8 b0 = *(const LAS bf16x8*)(Kslot + kimg(r32, 2 * d0 + hi)), b1 = *(const LAS bf16x8*)(Kslot + 4096 + kimg(r32, 2 * d0 + hi));
        p0 = __builtin_amdgcn_mfma_f32_32x32x16_bf16(b0, qr[d0], p0, 0, 0, 0); p1 = __builtin_amdgcn_mfma_f32_32x32x16_bf16(b1, qr[d0], p1, 0, 0, 0); }
}
__device__ __forceinline__ void pv(f32x16* o, int vb, bf16x8 pa0, bf16x8 pa1, bf16x8 pa2, bf16x8 pa3) {
    s16x4 lo[2][4], hi[2][4];
#pragma unroll
    for (int d0 = 0; d0 < 2; ++d0)
#pragma unroll
        for (int ks = 0; ks < 4; ++ks) {
            asm volatile("ds_read_b64_tr_b16 %0,%1 offset:%c2" : "=&v"(lo[d0][ks]) : "v"(vb), "i"(d0 * 4096 + ks * 1024) : "memory");
            asm volatile("ds_read_b64_tr_b16 %0,%1 offset:%c2" : "=&v"(hi[d0][ks]) : "v"(vb), "i"(d0 * 4096 + ks * 1024 + 512) : "memory"); }
#define ATT_PK(d, k) (bf16x8){lo[d][k][0], lo[d][k][1], lo[d][k][2], lo[d][k][3], hi[d][k][0], hi[d][k][1], hi[d][k][2], hi[d][k][3]}
    asm volatile("s_waitcnt lgkmcnt(8)" ::: "memory"); __builtin_amdgcn_sched_barrier(0);
    o[0] = __builtin_amdgcn_mfma_f32_32x32x16_bf16(pa0, ATT_PK(0, 0), o[0], 0, 0, 0);
    o[0] = __builtin_amdgcn_mfma_f32_32x32x16_bf16(pa1, ATT_PK(0, 1), o[0], 0, 0, 0);
    o[0] = __builtin_amdgcn_mfma_f32_32x32x16_bf16(pa2, ATT_PK(0, 2), o[0], 0, 0, 0);
    o[0] = __builtin_amdgcn_mfma_f32_32x32x16_bf16(pa3, ATT_PK(0, 3), o[0], 0, 0, 0);
    asm volatile("s_waitcnt lgkmcnt(0)" ::: "memory"); __builtin_amdgcn_sched_barrier(0);
    o[1] = __builtin_amdgcn_mfma_f32_32x32x16_bf16(pa0, ATT_PK(1, 0), o[1], 0, 0, 0);
    o[1] = __builtin_amdgcn_mfma_f32_32x32x16_bf16(pa1, ATT_PK(1, 1), o[1], 0, 0, 0);
    o[1] = __builtin_amdgcn_mfma_f32_32x32x16_bf16(pa2, ATT_PK(1, 2), o[1], 0, 0, 0);
    o[1] = __builtin_amdgcn_mfma_f32_32x32x16_bf16(pa3, ATT_PK(1, 3), o[1], 0, 0, 0);
#undef ATT_PK
}
__device__ __forceinline__ float half_swap_max(float m) { auto rr = __builtin_amdgcn_permlane32_swap(__float_as_uint(m), __float_as_uint(m), false, false); return fmaxf(__uint_as_float(rr[0]), __uint_as_float(rr[1])); }
__device__ __forceinline__ float half_swap_sum(float m) { auto rr = __builtin_amdgcn_permlane32_swap(__float_as_uint(m), __float_as_uint(m), false, false); return __uint_as_float(rr[0]) + __uint_as_float(rr[1]); }
__device__ __forceinline__ void softmax_pv(f32x16& p0, f32x16& p1, float& m_run, float& l_run, f32x16* o, int vb, LAS float* wsf, int r32, int hi) {
    float mx = p0[0];
#pragma unroll
    for (int r = 1; r < 16; ++r) mx = fmaxf(mx, p0[r]);
#pragma unroll
    for (int r = 0; r < 16; ++r) mx = fmaxf(mx, p1[r]);
    mx = half_swap_max(mx);
    const float mnew = fmaxf(m_run, mx), msafe = (mnew == -INFINITY) ? 0.f : mnew;
    const float alpha = __builtin_amdgcn_exp2f(m_run - msafe);
    m_run = mnew;
    float rs = 0.f;
#pragma unroll
    for (int r = 0; r < 16; ++r) { p0[r] = __builtin_amdgcn_exp2f(p0[r] - msafe); p1[r] = __builtin_amdgcn_exp2f(p1[r] - msafe); rs += p0[r] + p1[r]; }
    l_run = l_run * alpha + rs;
    if (__any(alpha != 1.0f)) {
        if (hi == 0) wsf[r32] = alpha;
        asm volatile("s_waitcnt lgkmcnt(0)" ::: "memory");
#pragma unroll
        for (int g = 0; g < 4; ++g) { const f32x4 a4 = *(const LAS f32x4*)(wsf + 8 * g + 4 * hi);
#pragma unroll
            for (int i = 0; i < 4; ++i) { o[0][4 * g + i] *= a4[i]; o[1][4 * g + i] *= a4[i]; } }
    }
    u32x4 pw0, pw1, pw2, pw3;
    pw0 = (u32x4){cvtpk(p0[0], p0[1]), cvtpk(p0[2], p0[3]), cvtpk(p0[4], p0[5]), cvtpk(p0[6], p0[7])}; pw1 = (u32x4){cvtpk(p0[8], p0[9]), cvtpk(p0[10], p0[11]), cvtpk(p0[12], p0[13]), cvtpk(p0[14], p0[15])};
    pw2 = (u32x4){cvtpk(p1[0], p1[1]), cvtpk(p1[2], p1[3]), cvtpk(p1[4], p1[5]), cvtpk(p1[6], p1[7])}; pw3 = (u32x4){cvtpk(p1[8], p1[9]), cvtpk(p1[10], p1[11]), cvtpk(p1[12], p1[13]), cvtpk(p1[14], p1[15])};
    pv(o, vb, __builtin_bit_cast(bf16x8, pw0), __builtin_bit_cast(bf16x8, pw1), __builtin_bit_cast(bf16x8, pw2), __builtin_bit_cast(bf16x8, pw3));
}
template <class RowOff>
__device__ __forceinline__ void store_o(const f32x16* o, float l_run, LAS float* wsf, LAS bf16_t* stg, bf16_t* Obase, const RowOff& rowoff, int lane, int r32, int hi) {
    const float lt = half_swap_sum(l_run);
    if (hi == 0) wsf[32 + r32] = lt;
    asm volatile("s_waitcnt lgkmcnt(0)" ::: "memory");
    float rli[16];
#pragma unroll
    for (int g = 0; g < 4; ++g) { const f32x4 a4 = *(const LAS f32x4*)(wsf + 32 + 8 * g + 4 * hi);
#pragma unroll
        for (int i = 0; i < 4; ++i) rli[4 * g + i] = __builtin_amdgcn_rcpf(a4[i]); }
#pragma unroll
    for (int r = 0; r < 16; ++r) { const int orow = crow(r, hi);
#pragma unroll
        for (int d0 = 0; d0 < 2; ++d0) stg[orow * 64 + d0 * 32 + r32] = (bf16_t)f2bf(o[d0][r] * rli[r]); }
    asm volatile("s_waitcnt lgkmcnt(0)" ::: "memory");
#pragma unroll
    for (int i = 0; i < 4; ++i) { const int row = i * 8 + (lane >> 3), ch = lane & 7; const u32x4 v = *(const LAS u32x4*)(stg + row * 64 + ch * 8); *(u32x4*)(Obase + rowoff(row) + ch * 8) = v; }
    asm volatile("s_waitcnt lgkmcnt(0)" ::: "memory");
}

typedef short s16x4 __attribute__((ext_vector_type(4)));
constexpr int F_RING = 0, F_KB = 65536, F_WS = 131072 + 64;
constexpr float F_THR = 8.0f;
__device__ __forceinline__ void fox_unit(const Ctx& c, int b, int h, int qb, const bf16_t* QKV, const float* KB3, bf16_t* MER, float kmaxn) {
    const int lane = c.lane, r32 = lane & 31, hi = lane >> 5, wid = c.wave;
    const size_t rowbase = (size_t)b * SEQ; const int q0 = qb * 256, NT = (q0 + 256) / 64;
    const bf16_t* Qw = QKV + (rowbase + q0 + wid * 32) * QKV0_LD + h * 64;
    const bf16_t* Kh = QKV + rowbase * QKV0_LD + 512 + h * 64; const bf16_t* Vh = QKV + rowbase * QKV0_LD + 1024 + h * 64;
    const unsigned lds0 = (unsigned)(size_t)c.lds;
    LAS float* wsf = (LAS float*)(c.lds + F_WS) + wid * 64;
    { const u32x4* src = (const u32x4*)((const u32x2*)KB3 + (size_t)(b * 8 + h) * SEQ); LAS u32x4* dst = (LAS u32x4*)(c.lds + F_KB); for (int i = c.tid; i < NT * 32; i += 512) dst[i] = src[i];
      if (c.tid == 0) *(LAS u32x2*)(c.lds + F_KB + 65536) = (u32x2){0x3f803f80u, 0u}; }
    bf16x8 qr[4];
#pragma unroll
    for (int d0 = 0; d0 < 4; ++d0) qr[d0] = *(const bf16x8*)(Qw + (size_t)r32 * QKV0_LD + d0 * 16 + hi * 8);
    const int krow = wid * 8 + (lane >> 3);
    const bf16_t* ksrc = Kh + (size_t)krow * QKV0_LD + (((lane & 7) ^ ((krow >> 1) & 7)) * 8);
    const bf16_t* vsrc = Vh + (size_t)(16 * (wid & 3) + (lane >> 2)) * QKV0_LD + (wid >> 2) * 32 + (lane & 3) * 8;
    const unsigned kdst = lds0 + F_RING + wid * 1024, vdst = lds0 + F_RING + 8192 + wid * 1024;
#define FOX_DMA(t, slot) do { glds16(ksrc + (size_t)(t) * 64 * QKV0_LD, (unsigned)__builtin_amdgcn_readfirstlane(kdst + (slot) * 16384)); glds16(vsrc + (size_t)(t) * 64 * QKV0_LD, (unsigned)__builtin_amdgcn_readfirstlane(vdst + (slot) * 16384)); } while (0)
#define FOX_KLOAD(slot) do { const LAS unsigned char* kb_ = c.lds + F_RING + (slot) * 16384; \
        _Pragma("unroll") for (int d0 = 0; d0 < 4; ++d0) { kf[2 * d0] = *(const LAS bf16x8*)(kb_ + kimg(r32, 2 * d0 + hi)); kf[2 * d0 + 1] = *(const LAS bf16x8*)(kb_ + 4096 + kimg(r32, 2 * d0 + hi)); } } while (0)
    const int vb0 = (int)(lds0 + F_RING + 8192) + ((lane >> 4) & 1) * 32 + (lane & 3) * 8 + (4 * hi + ((lane & 15) >> 2)) * 64;
    {
        u32x4 q0_ = __builtin_bit_cast(u32x4, qr[0]), q1_ = __builtin_bit_cast(u32x4, qr[1]), q2_ = __builtin_bit_cast(u32x4, qr[2]), q3_ = __builtin_bit_cast(u32x4, qr[3]);
        asm volatile("" : "+v"(q0_), "+v"(q1_), "+v"(q2_), "+v"(q3_));
        qr[0] = __builtin_bit_cast(bf16x8, q0_); qr[1] = __builtin_bit_cast(bf16x8, q1_); qr[2] = __builtin_bit_cast(bf16x8, q2_); qr[3] = __builtin_bit_cast(bf16x8, q3_); }
    int ts;
    { float qn = 0.f;
#pragma unroll
      for (int d0 = 0; d0 < 4; ++d0) { const u32x4 w_ = __builtin_bit_cast(u32x4, qr[d0]);
#pragma unroll
          for (int e = 0; e < 4; ++e) { const float lo_ = bf2f((unsigned short)(w_[e] & 0xffffu)), hi_ = bf2f((unsigned short)(w_[e] >> 16)); qn += lo_ * lo_ + hi_ * hi_; } }
      float sqq = 0.f; { const bf16_t* kq = Kh + (size_t)(q0 + wid * 32 + r32) * QKV0_LD + hi * 8;
#pragma unroll
        for (int d0 = 0; d0 < 4; ++d0) { const u32x4 w_ = __builtin_bit_cast(u32x4, qr[d0]), k_ = *(const u32x4*)(kq + d0 * 16);
#pragma unroll
            for (int e = 0; e < 4; ++e) sqq += bf2f((unsigned short)(w_[e] & 0xffffu)) * bf2f((unsigned short)(k_[e] & 0xffffu)) + bf2f((unsigned short)(w_[e] >> 16)) * bf2f((unsigned short)(k_[e] >> 16)); } }
      qn = half_swap_sum(qn); sqq = half_swap_sum(sqq);
      asm volatile("s_waitcnt vmcnt(0) lgkmcnt(0)\n\ts_barrier" ::: "memory");
      const LAS u32x2* kbp = (const LAS u32x2*)(c.lds + F_KB);
#define FOX_KBV(k_) ({ const u32x2 w_ = kbp[(k_)]; bf2f((unsigned short)(w_.x & 0xffffu)) + bf2f((unsigned short)(w_.x >> 16)) + bf2f((unsigned short)(w_.y & 0xffffu)); })
      float lq = sqq + FOX_KBV(q0 + wid * 32 + r32);
#pragma unroll
      for (int o_ = 1; o_ < 32; o_ <<= 1) { qn = fmaxf(qn, __shfl_xor(qn, o_)); lq = fminf(lq, __shfl_xor(lq, o_)); }
      LAS float* qm = (LAS float*)(c.lds + F_WS + 2048);
      if (lane == 0) { qm[wid] = qn; qm[8 + wid] = lq; }
      asm volatile("s_waitcnt lgkmcnt(0)\n\ts_barrier" ::: "memory");
      float qmax = qm[0], lmin = qm[8];
#pragma unroll
      for (int w_ = 1; w_ < 8; ++w_) { qmax = fmaxf(qmax, qm[w_]); lmin = fminf(lmin, qm[8 + w_]); }
      const float thr = lmin - 42.f - sqrtf(qmax) * kmaxn;
      int lo_ = 0, hi_ = 4 * qb;
#pragma unroll 1
      for (int it = 0; it < 8; ++it) { const int mid = (lo_ + hi_ + 1) >> 1; const bool okc = (mid == 0) || (FOX_KBV(64 * mid - 1) <= thr); lo_ = okc ? mid : lo_; hi_ = okc ? hi_ : mid - 1; }
#undef FOX_KBV
      ts = __builtin_amdgcn_readfirstlane(lo_); }
    asm volatile("s_waitcnt vmcnt(0)" ::: "memory");
    FOX_DMA(ts, 0); FOX_DMA(ts + 1, 1); FOX_DMA(ts + 2, 2);
    float mhat = 0.f, l_run = 0.f; f32x16 o[2]; o[0] = f32x16{}; o[1] = f32x16{};
    s16x4 qside = hi ? (s16x4){0, 0, 0, 0} : (s16x4){(short)0x3f80, (short)0x3f80, (short)0x3f80, 0};
    const int qrel = wid * 32 + r32;
    bf16x8 kf[8];
    const bool late = wid >= 4;
    asm volatile("s_waitcnt vmcnt(4) lgkmcnt(0)\n\ts_barrier" ::: "memory");
    int slot = 0;
    const LAS unsigned char* kbrd = c.lds + F_KB + (hi ? 65536 : r32 * 8 + ts * 512);
    const int kbstep = hi ? 0 : 512;
    f32x16 p0, p1;
#define FOX_QK(t_) do { __builtin_amdgcn_s_setprio(1); \
        p0 = __builtin_amdgcn_mfma_f32_32x32x16_bf16(kf[0], qr[0], f32x16{}, 0, 0, 0); p1 = __builtin_amdgcn_mfma_f32_32x32x16_bf16(kf[1], qr[0], f32x16{}, 0, 0, 0); \
        _Pragma("unroll") for (int d0 = 1; d0 < 4; ++d0) { p0 = __builtin_amdgcn_mfma_f32_32x32x16_bf16(kf[2 * d0], qr[d0], p0, 0, 0, 0); p1 = __builtin_amdgcn_mfma_f32_32x32x16_bf16(kf[2 * d0 + 1], qr[d0], p1, 0, 0, 0); } \
        { const s16x4 b0 = *(const LAS s16x4*)(kbrd), b1 = *(const LAS s16x4*)(kbrd + (hi ? 0 : 256)); kbrd += kbstep; \
          p0 = __builtin_amdgcn_mfma_f32_32x32x8bf16_1k(b0, qside, p0, 0, 0, 0); p1 = __builtin_amdgcn_mfma_f32_32x32x8bf16_1k(b1, qside, p1, 0, 0, 0); } __builtin_amdgcn_s_setprio(0); } while (0)
#define FOX_TOP(t_) do { if ((t_) + 2 < NT) asm volatile("s_waitcnt vmcnt(2) lgkmcnt(0)\n\ts_barrier" ::: "memory"); else asm volatile("s_waitcnt vmcnt(0) lgkmcnt(0)\n\ts_barrier" ::: "memory");     \
        if ((t_) + 3 < NT) { const int s3 = (slot + 3) & 3; FOX_DMA((t_) + 3, s3); } } while (0)
#define FOX_SOFTMAX_PV(t_) do { \
        const int jb = (t_) - (NT - 4); \
        if (jb >= 0) { const int kb = 64 * jb + 4 * hi; \
            _Pragma("unroll") for (int r = 0; r < 16; ++r) { const int kv = kb + (r & 3) + 8 * (r >> 2); if (kv > qrel) p0[r] = -INFINITY; if (kv + 32 > qrel) p1[r] = -INFINITY; } } \
        float mx = p0[0]; \
        _Pragma("unroll") for (int r = 1; r < 16; ++r) mx = fmaxf(mx, p0[r]); \
        _Pragma("unroll") for (int r = 0; r < 16; ++r) mx = fmaxf(mx, p1[r]); \
        mx = half_swap_max(mx); \
        if ((t_) == ts || __any(mx > F_THR)) {            \
            float dl = ((t_) == ts) ? mx : fmaxf(mx, 0.f); \
            const float mnew = mhat + dl; const unsigned mh = f2bf(mnew); const float r1 = mnew - bf2f((unsigned short)mh); const unsigned ml = f2bf(r1); const float mq = bf2f((unsigned short)mh) + bf2f((unsigned short)ml); \
            dl = mq - mhat; mhat = mq; \
            if (hi) { qside[0] = (short)(mh ^ 0x8000u); qside[1] = (short)(ml ^ 0x8000u); } \
            _Pragma("unroll") for (int r = 0; r < 16; ++r) { p0[r] -= dl; p1[r] -= dl; } \
            const float f = __builtin_amdgcn_exp2f(-dl); l_run *= f; \
            if (hi == 0) wsf[r32] = f; \
            asm volatile("s_waitcnt lgkmcnt(0)" ::: "memory"); \
            _Pragma("unroll") for (int g = 0; g < 4; ++g) { const f32x4 a4 = *(const LAS f32x4*)(wsf + 8 * g + 4 * hi); \
                _Pragma("unroll") for (int i = 0; i < 4; ++i) { o[0][4 * g + i] *= a4[i]; o[1][4 * g + i] *= a4[i]; } } \
        } \
        float rs = 0.f; \
        _Pragma("unroll") for (int r = 0; r < 16; ++r) { p0[r] = __builtin_amdgcn_exp2f(p0[r]); p1[r] = __builtin_amdgcn_exp2f(p1[r]); rs += p0[r] + p1[r]; } \
        l_run += rs; \
        u32x4 pw0, pw1, pw2, pw3; \
        pw0 = (u32x4){cvtpk(p0[0], p0[1]), cvtpk(p0[2], p0[3]), cvtpk(p0[4], p0[5]), cvtpk(p0[6], p0[7])}; pw1 = (u32x4){cvtpk(p0[8], p0[9]), cvtpk(p0[10], p0[11]), cvtpk(p0[12], p0[13]), cvtpk(p0[14], p0[15])}; \
        pw2 = (u32x4){cvtpk(p1[0], p1[1]), cvtpk(p1[2], p1[3]), cvtpk(p1[4], p1[5]), cvtpk(p1[6], p1[7])}; pw3 = (u32x4){cvtpk(p1[8], p1[9]), cvtpk(p1[10], p1[11]), cvtpk(p1[12], p1[13]), cvtpk(p1[14], p1[15])}; \
        pv(o, vb0 + slot * 16384, __builtin_bit_cast(bf16x8, pw0), __builtin_bit_cast(bf16x8, pw1), __builtin_bit_cast(bf16x8, pw2), __builtin_bit_cast(bf16x8, pw3)); } while (0)
#pragma unroll 1
    for (int t = ts; t < NT; ++t) {
        if (!late) FOX_TOP(t);
        FOX_KLOAD(slot); FOX_QK(t);
        if (late) FOX_TOP(t);
        FOX_SOFTMAX_PV(t);
        slot = (slot + 1) & 3;
    }
#undef FOX_QK
#undef FOX_TOP
#undef FOX_SOFTMAX_PV
#undef FOX_DMA
#undef FOX_KLOAD
    asm volatile("s_waitcnt lgkmcnt(0)\n\ts_barrier" ::: "memory");
    bf16_t* Ow = MER + (rowbase + q0 + wid * 32) * MER_LD + h * 64;
    store_o(o, l_run, wsf, (LAS bf16_t*)(c.lds + F_RING) + wid * 2048, Ow, [](int row) { return (size_t)row * MER_LD; }, lane, r32, hi);
    asm volatile("s_waitcnt vmcnt(0) lgkmcnt(0)\n\ts_barrier" ::: "memory");
}
__device__ __forceinline__ void fox_scan(const Ctx& c, const float* LF, float* KB2, int bh) {
    LAS float* part = (LAS float*)(c.lds + 140 * 1024);
    const float* src = LF + (size_t)bh * SEQ + c.tid * 16; float v[16];
#pragma unroll
    for (int i = 0; i < 4; ++i) { const f32x4 q = ((const f32x4*)src)[i]; v[4 * i] = q.x; v[4 * i + 1] = q.y; v[4 * i + 2] = q.z; v[4 * i + 3] = q.w; }
#pragma unroll
    for (int i = 1; i < 16; ++i) v[i] += v[i - 1];
    part[c.tid] = v[15];
    __syncthreads();
    if (c.tid < 64) { float s[8]; float run = 0.f;
#pragma unroll
        for (int i = 0; i < 8; ++i) { run += part[c.tid * 8 + i]; s[i] = run; }
        float inc = run;
#pragma unroll
        for (int o = 1; o < 64; o <<= 1) { const float u = __shfl_up(inc, o); if (c.lane >= o) inc += u; }
        const float base = inc - run;
#pragma unroll
        for (int i = 0; i < 8; ++i) part[c.tid * 8 + i] = base + s[i]; }
    __syncthreads();
    const float off = (c.tid > 0) ? part[c.tid - 1] : 0.f;
    u32x2* dst = (u32x2*)KB2 + (size_t)bh * SEQ + c.tid * 16;
#pragma unroll
    for (int i = 0; i < 16; ++i) { const float kb = -LOG2E * (v[i] + off); const unsigned h1 = f2bf(kb); const float r1 = kb - bf2f((unsigned short)h1); const unsigned h2 = f2bf(r1); const float r2 = r1 - bf2f((unsigned short)h2); const unsigned h3 = f2bf(r2);
        u32x2 w; w.x = h1 | (h2 << 16); w.y = h3; dst[i] = w; }
    __syncthreads();
}

constexpr int D_TILE = 0, D_TB = 131072, D_WS = 131072 + 6400;
__device__ __forceinline__ float t5_bucket_f(int dist) { if (dist < 16) return (float)dist; const int l = 16 + (int)(logf((float)dist * (1.0f / 16.0f)) / logf(128.0f) * 16.0f); return (float)(l < 31 ? l : 31); }
__device__ __forceinline__ void dil_tables(const Ctx& c, const float* relb) {
    LAS float* TB = (LAS float*)(c.lds + D_TB);
    for (int i = c.tid; i < 12 * 131; i += 512) { const int hd = i / 131, n = i % 131 - 1, g = hd >> 2; const int r = (g == 0) ? 1 : (g == 1 ? 4 : 16);
        TB[hd * 132 + 1 + n] = (n < 0 || n > 128) ? -INFINITY : relb[(int)t5_bucket_f(r * n) * 16 + hd] * LOG2E; }
    __syncthreads();
}
__device__ __forceinline__ void dil_unit(const Ctx& c, int u, const bf16_t* QKV, bf16_t* MER) {
    const int lane = c.lane, r32 = lane & 31, hi = lane >> 5, wid = c.wave;
    const int mb = u & 15, cc = (u >> 4) & 15, j = (u >> 8) & 3, b = u >> 10, m0 = mb * 32;
    const size_t rowbase = (size_t)b * SEQ;
    const unsigned lds0 = (unsigned)(size_t)c.lds;
    LAS unsigned char* tile = c.lds + D_TILE + wid * 16384;
    const unsigned tile0 = lds0 + D_TILE + wid * 16384;
    LAS float* wsf = (LAS float*)(c.lds + D_WS) + wid * 64;
    const LAS float* TB = (const LAS float*)(c.lds + D_TB);
    const int vb0 = (int)tile0 + ((lane >> 4) & 1) * 32 + (lane & 3) * 8 + (4 * hi + ((lane & 15) >> 2)) * 64;
    const int tq = 16 * (m0 + r32) + cc;
    float m_run = -INFINITY, l_run = 0.f; f32x16 o[2]; o[0] = f32x16{}; o[1] = f32x16{};
#pragma unroll 1
    for (int g = 0; g < 3; ++g) {
        const int r = (g == 0) ? 1 : (g == 1 ? 4 : 16), lr = (g == 0) ? 0 : (g == 1 ? 2 : 4), sr = 16 >> lr, cr = cc & (r - 1), hd = g * 4 + j;
        const bf16_t* Qh = QKV + rowbase * QKV0_LD + 1536 + hd * 64; const bf16_t* Kh = QKV + rowbase * QKV0_LD + 2304 + hd * 64; const bf16_t* Vh = QKV + rowbase * QKV0_LD + 3072 + hd * 64;
        bf16x8 qr[4];
#pragma unroll
        for (int d0 = 0; d0 < 4; ++d0) qr[d0] = *(const bf16x8*)(Qh + (size_t)tq * QKV0_LD + d0 * 16 + hi * 8);
        const int uq = (tq - cr) >> lr;
        const int u0 = ((16 * m0 + cc - cr) >> lr) - 128;
        const int nk = 128 + 31 * sr + 1, ntile = (nk + 63) >> 6;
        const LAS float* tb = TB + hd * 132;
#define DIL_KEYTOK(uk_) ({ int uk__ = (uk_); uk__ = uk__ < 0 ? 0 : uk__; int tk__ = (uk__ << lr) + cr; tk__ > SEQ - 1 ? SEQ - 1 : tk__; })
#define DIL_LOADK(dst, t_) do { const int ub_ = u0 + 64 * (t_); const bf16_t* k0_ = Kh + (size_t)DIL_KEYTOK(ub_ + r32) * QKV0_LD + hi * 8; const bf16_t* k1_ = Kh + (size_t)DIL_KEYTOK(ub_ + 32 + r32) * QKV0_LD + hi * 8; \
            _Pragma("unroll") for (int d0 = 0; d0 < 4; ++d0) { dst[2 * d0] = *(const bf16x8*)(k0_ + 16 * d0); dst[2 * d0 + 1] = *(const bf16x8*)(k1_ + 16 * d0); } } while (0)
#define DIL_DMAV(t_) do { const int ub_ = u0 + 64 * (t_); _Pragma("unroll") for (int w = 0; w < 8; ++w) { const int tk_ = DIL_KEYTOK(ub_ + 16 * (w & 3) + (lane >> 2)); \
            __builtin_amdgcn_global_load_lds((const unsigned*)(Vh + (size_t)tk_ * QKV0_LD + (w >> 2) * 32 + (lane & 3) * 8), (LAS unsigned*)(tile + ((t_) & 1) * 8192 + w * 1024), 16, 0, 0); } } while (0)
#define DIL_TILE(kf_, t_) do { const int ub = u0 + 64 * (t_); \
            f32x16 p0 = f32x16{}, p1 = f32x16{}; \
            _Pragma("unroll") for (int d0 = 0; d0 < 4; ++d0) { p0 = __builtin_amdgcn_mfma_f32_32x32x16_bf16(kf_[2 * d0], qr[d0], p0, 0, 0, 0); p1 = __builtin_amdgcn_mfma_f32_32x32x16_bf16(kf_[2 * d0 + 1], qr[d0], p1, 0, 0, 0); } \
            const int nb = uq - ub - 4 * hi; \
            _Pragma("unroll") for (int rr = 0; rr < 16; ++rr) { const int kc = (rr & 3) + 8 * (rr >> 2);            \
                p0[rr] += tb[max(-1, min(nb - kc, 129)) + 1]; p1[rr] += tb[max(-1, min(nb - kc - 32, 129)) + 1]; } \
            if (ub < 0) {            \
                _Pragma("unroll") for (int rr = 0; rr < 16; ++rr) { const int kv = crow(rr, hi); p0[rr] = (ub + kv >= 0) ? p0[rr] : -INFINITY; p1[rr] = (ub + kv + 32 >= 0) ? p1[rr] : -INFINITY; } } \
            softmax_pv(p0, p1, m_run, l_run, o, vb0 + ((t_) & 1) * 8192, wsf, r32, hi); } while (0)
        bf16x8 kfa[8], kfb[8];
        asm volatile("s_waitcnt lgkmcnt(0)" ::: "memory");
        DIL_DMAV(0); DIL_LOADK(kfa, 0);
#pragma unroll 1
        for (int t = 0; t < ntile; t += 2) {
            if (t + 1 < ntile) { asm volatile("s_waitcnt lgkmcnt(0)" ::: "memory"); DIL_DMAV(t + 1); DIL_LOADK(kfb, t + 1); asm volatile("s_waitcnt vmcnt(16)" ::: "memory"); } else asm volatile("s_waitcnt vmcnt(0)" ::: "memory");
            DIL_TILE(kfa, t);
            if (t + 1 < ntile) {
                if (t + 2 < ntile) { asm volatile("s_waitcnt lgkmcnt(0)" ::: "memory"); DIL_DMAV(t + 2); DIL_LOADK(kfa, t + 2); asm volatile("s_waitcnt vmcnt(16)" ::: "memory"); } else asm volatile("s_waitcnt vmcnt(0)" ::: "memory");
                DIL_TILE(kfb, t + 1);
            }
        }
#undef DIL_KEYTOK
#undef DIL_LOADK
#undef DIL_DMAV
#undef DIL_TILE
    }
    asm volatile("s_waitcnt lgkmcnt(0)" ::: "memory");
    bf16_t* Ob = MER + (rowbase + 16 * m0 + cc) * MER_LD + 512 + j * 64;
    store_o(o, l_run, wsf, (LAS bf16_t*)tile, Ob, [](int row) { return (size_t)row * 16 * MER_LD; }, lane, r32, hi);
}
}
namespace dsa {
typedef _Float16 f16x8 __attribute__((ext_vector_type(8)));
using att::glds16;
constexpr float FP8_SCK = 16.f;
__device__ __forceinline__ void ckv_norm(const Ctx& c, const bf16_t* CKV, const float* g, unsigned char* CKVN) {
    const f32x4 gv = *((const f32x4*)g + c.lane);
    for (int row0 = (c.vcu * 8 + c.wave) * 4; row0 < NTOK; row0 += c.G * 8 * 4) {
        u32x2 y[4];
#pragma unroll
        for (int r = 0; r < 4; ++r) y[r] = *((const u32x2*)(CKV + (size_t)(row0 + r) * 256) + c.lane);
#pragma unroll
        for (int r = 0; r < 4; ++r) {
            f32x4 v; v.x = __builtin_bit_cast(float, y[r].x << 16); v.y = __builtin_bit_cast(float, y[r].x & 0xffff0000u); v.z = __builtin_bit_cast(float, y[r].y << 16); v.w = __builtin_bit_cast(float, y[r].y & 0xffff0000u);
            const float rs = 1.0f / sqrtf(wave_sum(dot4(v, v)) * (1.0f / 256.0f) + EPS);
            v = (v * rs) * gv;
            *((unsigned*)(CKVN + (size_t)(row0 + r) * 256) + c.lane) = pk4_fp8(v.x * FP8_SCK, v.y * FP8_SCK, v.z * FP8_SCK, v.w * FP8_SCK); }
    }
}
constexpr int NBIN = 512, CAP = 96;
constexpr int X_K = 0, X_H = 24576, X_BM = X_H, X_CAND = X_H + 65536, X_LS = X_CAND + 64 * CAP * 8, X_ROW = X_H + 131072, X_RED = X_ROW + 2048;
typedef _Float16 f16x2 __attribute__((ext_vector_type(2)));

__device__ __forceinline__ void idx_boundary(const Ctx& c) {
    const int lane = c.lane, wid = c.wave;
    LAS unsigned* HIST = (LAS unsigned*)(c.lds + X_H);
    LAS float* RLO = (LAS float*)(c.lds + X_ROW); LAS int* RBST = (LAS int*)(RLO + 128); LAS int* RNEED = (LAS int*)(RLO + 192);
    asm volatile("s_waitcnt lgkmcnt(0)" ::: "memory");
#pragma unroll 1
    for (int r = 0; r < 8; ++r) { const int rowl = wid * 8 + r; int cn[8]; int tot = 0;
        { const u32x4 h0 = *((const LAS u32x4*)(HIST + rowl * NBIN) + 2 * lane), h1 = *((const LAS u32x4*)(HIST + rowl * NBIN) + 2 * lane + 1);
          cn[0] = h0.x; cn[1] = h0.y; cn[2] = h0.z; cn[3] = h0.w; cn[4] = h1.x; cn[5] = h1.y; cn[6] = h1.z; cn[7] = h1.w; }
#pragma unroll
        for (int i = 0; i < 8; ++i) tot += cn[i];
        int suf = tot;
#pragma unroll
        for (int o = 1; o < 64; o <<= 1) { const int v = __shfl_down(suf, o); if (lane + o < 64) suf += v; }
        const int above_me = suf - tot;
        if (above_me < 256 && suf >= 256) { int acc = above_me, bb = 0, na = 0; bool found = false;
#pragma unroll
            for (int i = 7; i >= 0; --i) { if (!found) { if (acc + cn[i] >= 256) { bb = lane * 8 + i; na = acc; found = true; } else acc += cn[i]; } }
            RBST[rowl] = bb; RNEED[rowl] = 256 - na; }
    }
    asm volatile("s_waitcnt lgkmcnt(0)" ::: "memory");
}
template <int PASS, bool DIAG, int MODE = 0>
__device__ __forceinline__ void idx_tile(const Ctx& c, int t, unsigned long long* SCw, f16x8 (&bfr)[2][4], const _Float16* knext, const f16x8 (&af)[2][4], const f16x8 (&wa)[4], const f16x2 (&rv)[2], const f16x2 (&nl)[2], const int (&cut)[4]) {
    const int lane = c.lane, n32 = lane & 31, hi = lane >> 5, wid = c.wave;
    LAS unsigned* HIST = (LAS unsigned*)(c.lds + X_H);
    f32x16 s4[2];
#pragma unroll
    for (int H = 0; H < 2; ++H) {
        f32x16 d[2];
#pragma unroll
        for (int T = 0; T < 2; ++T) { d[T] = f32x16{};
#pragma unroll
            for (int ks = 0; ks < 4; ++ks) d[T] = __builtin_amdgcn_mfma_f32_32x32x16_f16(af[T][ks], bfr[H][ks], d[T], 0, 0, 0); }
        if (knext && !(MODE & 2)) {
#pragma unroll
            for (int ks = 0; ks < 4; ++ks) bfr[H][ks] = *(const f16x8*)(knext + (ks * 1024 + H * 256 - 2048)); }
        s4[H] = f32x16{};
#pragma unroll
        for (int s = 0; s < 4; ++s) {
            f16x8 rb;
#pragma unroll
            for (int j2 = 0; j2 < 4; ++j2) { const f16x2 z = {(_Float16)0.f, (_Float16)0.f}; f16x2 pr = __builtin_bit_cast(f16x2, __builtin_amdgcn_cvt_pkrtz(d[s >> 1][8 * (s & 1) + 2 * j2], d[s >> 1][8 * (s & 1) + 2 * j2 + 1]));
                pr = __builtin_elementwise_max(pr, z); rb[2 * j2] = pr[0]; rb[2 * j2 + 1] = pr[1]; }
            s4[H] = __builtin_amdgcn_mfma_f32_32x32x16_f16(wa[s], rb, s4[H], 0, 0, 0); }
        }
#pragma unroll
    for (int H = 0; H < 2; ++H) {
        const unsigned w0 = __builtin_bit_cast(unsigned, __builtin_amdgcn_cvt_pkrtz(s4[H][0], s4[H][1])), w1 = __builtin_bit_cast(unsigned, __builtin_amdgcn_cvt_pkrtz(s4[H][2], s4[H][3]));
        if (!(MODE & 4)) SCw[(size_t)(2 * t + H) * 512] = (unsigned long long)w0 | ((unsigned long long)w1 << 32);
        const f16x2 lo2 = {(_Float16)1024.f, (_Float16)1024.f}, hi2 = {(_Float16)1535.f, (_Float16)1535.f};
        unsigned bw[2];
#pragma unroll
        for (int p = 0; p < 2; ++p) { f16x2 v = __builtin_elementwise_fma(__builtin_bit_cast(f16x2, p ? w1 : w0), rv[p], nl[p]); v = __builtin_elementwise_min(__builtin_elementwise_max(v, lo2), hi2); bw[p] = __builtin_bit_cast(unsigned, v); }
        const int kloc = 32 * H + n32;
#pragma unroll
        for (int i = 0; i < 4; ++i) {
            const int rowl = wid * 8 + 4 * hi + i; const int bin = (i & 1) ? (int)((bw[i >> 1] >> 16) & 0x3FFu) : (int)(bw[i >> 1] & 0x3FFu);
            const bool cnt = (!DIAG || (kloc <= rowl)) && bin >= cut[i];
            if (cnt && !(MODE & 1)) __hip_atomic_fetch_add(HIST + rowl * NBIN + bin, 1u, __ATOMIC_RELAXED, __HIP_MEMORY_SCOPE_WORKGROUP);
            if (MODE & 1) asm volatile("" :: "v"(bin));
        }
    }
}
__device__ __forceinline__ int idx_bin(unsigned hb, _Float16 rv, _Float16 nl) {
    _Float16 v = __builtin_fmaf16(__builtin_bit_cast(_Float16, (unsigned short)hb), rv, nl); v = __builtin_fminf16(__builtin_fmaxf16(v, (_Float16)1024.f), (_Float16)1535.f);
    return (int)(__builtin_bit_cast(unsigned short, v) & 0x3FFu);
}
template <int PASS, int MODE = 0>
__device__ __forceinline__ void idx_tiles(const Ctx& c, int NT, unsigned long long* SCw, const _Float16* kt0, const f16x8 (&af)[2][4], const f16x8 (&wa)[4], const f16x2 (&rv)[2], const f16x2 (&nl)[2]) {
    const int lane = c.lane, n32 = lane & 31, hi = lane >> 5, wid = c.wave;
    const _Float16* kp = kt0 + 2048 + hi * 512 + n32 * 8;
#define IDX_LOADB(dst, t) do { _Pragma("unroll") for (int H = 0; H < 2; ++H) _Pragma("unroll") for (int ks = 0; ks < 4; ++ks) dst[H][ks] = *(const f16x8*)(kp + (size_t)(t) * 4096 + (ks * 1024 + H * 256 - 2048)); } while (0)
    int cut[4] = {0, 0, 0, 0};
    f16x8 b0[2][4];
    IDX_LOADB(b0, 0);
#pragma unroll 1
    for (int t = 0; t < NT - 1; ++t) {
        idx_tile<PASS, false, MODE>(c, t, SCw, b0, kp + (size_t)(t + 1) * 4096, af, wa, rv, nl, cut);
        if (PASS == 0 && MODE == 0 && t == 31 && t + 8 < NT) {
            idx_boundary(c);
            LAS int* RBST = (LAS int*)((LAS float*)(c.lds + X_ROW) + 128);
#pragma unroll
            for (int i = 0; i < 4; ++i) cut[i] = RBST[wid * 8 + 4 * hi + i];
        }
    }
    if (MODE == 0) idx_tile<PASS, true>(c, NT - 1, SCw, b0, nullptr, af, wa, rv, nl, cut);
#undef IDX_LOADB
}

template <bool DIAG>
__device__ __forceinline__ void idx_emit_tile(const Ctx& c, int t, const unsigned long long (&cur)[2], const unsigned (&thi)[8], const unsigned (&tlo)[8], int (&ca)[8], int (&cc)[8]) {
    const int lane = c.lane, wid = c.wave;
    LAS unsigned short* LIST = (LAS unsigned short*)(c.lds + X_BM); LAS unsigned* CANDC = (LAS unsigned*)(c.lds + X_CAND);
#pragma unroll
    for (int g = 0; g < 2; ++g)
#pragma unroll
        for (int i = 0; i < 4; ++i) {
            const int r = 4 * g + i, rowl = wid * 8 + r; const unsigned hb = (unsigned)(cur[g] >> (16 * i)) & 0xFFFFu; const _Float16 x = __builtin_bit_cast(_Float16, (unsigned short)hb);
            const bool ok = !DIAG || (lane <= rowl);
            const bool above = ok && (x >= __builtin_bit_cast(_Float16, (unsigned short)thi[r])), ge = ok && (x >= __builtin_bit_cast(_Float16, (unsigned short)tlo[r]));
            const unsigned long long ma = __ballot(above), me = __ballot(ge) & ~ma;
            if (above) { const int p = (int)__builtin_amdgcn_mbcnt_hi((unsigned)(ma >> 32), __builtin_amdgcn_mbcnt_lo((unsigned)ma, (unsigned)ca[r])); if (p < 256) LIST[rowl * 256 + p] = (unsigned short)(64 * t + lane); }
            ca[r] += __popcll(ma);
            if (me != 0ull) {
                if (ge && !above) { const int p = (int)__builtin_amdgcn_mbcnt_hi((unsigned)(me >> 32), __builtin_amdgcn_mbcnt_lo((unsigned)me, (unsigned)cc[r]));
                    if (p < CAP) { const unsigned h0 = (hb == 0x8000u) ? 0u : hb; const unsigned neg = (unsigned)((int)(h0 << 16) >> 31);
                        CANDC[rowl * CAP + p] = ((h0 ^ (0x8000u | (neg & 0x7FFFu))) << 16) | (0xFFFFu - (unsigned)(64 * t + lane)); } }
                cc[r] += __popcll(me);
            }
        }
}
__device__ __forceinline__ void idx_emit(const Ctx& c, int NT, const unsigned long long* SCblk, const unsigned (&thi)[8], const unsigned (&tlo)[8]) {
    const int lane = c.lane, wid = c.wave;
    LAS int* CCNT = (LAS int*)(c.lds + X_RED) + 64; LAS int* CABV = (LAS int*)(c.lds + X_RED) + 128;
    const unsigned long long* rp = SCblk + wid * 64 + (lane >> 5) * 512 + (lane & 31);
    int cc[8], ca[8];
#pragma unroll
    for (int r = 0; r < 8; ++r) { cc[r] = 0; ca[r] = 0; }
    unsigned long long cur[2], nxt[2];
#pragma unroll
    for (int g = 0; g < 2; ++g) cur[g] = __hip_atomic_load(rp + g * 32, __ATOMIC_RELAXED, __HIP_MEMORY_SCOPE_AGENT);
#pragma unroll 1
    for (int t = 0; t < NT - 1; ++t) {
#pragma unroll
        for (int g = 0; g < 2; ++g) nxt[g] = __hip_atomic_load(rp + (size_t)(t + 1) * 1024 + g * 32, __ATOMIC_RELAXED, __HIP_MEMORY_SCOPE_AGENT);
        idx_emit_tile<false>(c, t, cur, thi, tlo, ca, cc);
        cur[0] = nxt[0]; cur[1] = nxt[1];
    }
    idx_emit_tile<true>(c, NT - 1, cur, thi, tlo, ca, cc);
    if (lane == 0) {
#pragma unroll
        for (int r = 0; r < 8; ++r) { CCNT[wid * 8 + r] = cc[r]; CABV[wid * 8 + r] = ca[r]; } }
}
__device__ __forceinline__ void idx_unit(const Ctx& c, int b, int qb, const bf16_t* QI, const bf16_t* KI, const float* WI, unsigned short* SEL, unsigned long long* SCblk) {
    int lane = c.lane; asm volatile("" : "+v"(lane));
    const int n32 = lane & 31, hi = lane >> 5, wid = c.wave, tid = wid * 64 + lane;
    const size_t rowbase = (size_t)b * SEQ; const int q0 = qb * 64, NT = qb + 1;
    if (qb < 4) {
        for (int r = 0; r < 8; ++r) { unsigned short* dst = SEL + (rowbase + q0 + wid * 8 + r) * 256;
#pragma unroll
            for (int i = 0; i < 4; ++i) dst[lane + 64 * i] = (unsigned short)(lane + 64 * i); }
        return;
    }
    const unsigned lds0 = (unsigned)(size_t)c.lds;
    LAS unsigned* HIST = (LAS unsigned*)(c.lds + X_H); LAS unsigned* BM = (LAS unsigned*)(c.lds + X_BM);
    LAS float* CANDS = (LAS float*)(c.lds + X_CAND); LAS int* CANDI = (LAS int*)(c.lds + X_CAND + 64 * CAP * 4);
    LAS float* RLO = (LAS float*)(c.lds + X_ROW); LAS float* RINV = RLO + 64; LAS int* RBST = (LAS int*)(RLO + 128); LAS int* RNEED = (LAS int*)(RLO + 192);
    LAS float* RED = (LAS float*)(c.lds + X_RED); LAS int* CCNT = (LAS int*)(c.lds + X_RED) + 64;
    const _Float16* KIh = (const _Float16*)KI + rowbase * 64; const _Float16* QIh = (const _Float16*)QI;
    float kmax = 0.f;
#ifdef PROBE_KMAX2
    for (int rep_ = 0; rep_ < 2; ++rep_)
#endif
    for (int k = tid; k < NT * 64; k += 512) { const _Float16* kp = KIh + (size_t)(k >> 6) * 4096 + (k & 63) * 8; float s = 0.f;
#pragma unroll
        for (int i = 0; i < 8; ++i) { const f16x8 v = *(const f16x8*)(kp + i * 512);
#pragma unroll
            for (int e = 0; e < 8; ++e) s += (float)v[e] * (float)v[e]; }
        kmax = fmaxf(kmax, s); }
#pragma unroll
    for (int o = 1; o < 64; o <<= 1) kmax = fmaxf(kmax, __shfl_xor(kmax, o));
    if (lane == 0) RED[wid] = kmax;
    for (int i = tid; i < 64 * NBIN; i += 512) HIST[i] = 0u;
    if (tid < 64) CCNT[tid] = 0;
    __syncthreads();
    kmax = RED[0];
#pragma unroll
    for (int w = 1; w < 8; ++w) kmax = fmaxf(kmax, RED[w]);
    kmax = sqrtf(kmax);
    { const int qw = lane >> 3, h = lane & 7; const size_t qrow = rowbase + q0 + wid * 8 + qw; const f16x8* qp = (const f16x8*)(QIh + qrow * 512 + h * 64); float s = 0.f;
#pragma unroll
      for (int i = 0; i < 8; ++i) { const f16x8 v = qp[i];
#pragma unroll
          for (int e = 0; e < 8; ++e) s += (float)v[e] * (float)v[e]; }
      const float w = (float)(_Float16)WI[qrow * 8 + h], cw = fabsf(w) * sqrtf(s) * kmax; float plus = w > 0.f ? cw : 0.f, minus = w < 0.f ? cw : 0.f;
#pragma unroll
      for (int o = 1; o < 8; o <<= 1) { plus += __shfl_xor(plus, o); minus += __shfl_xor(minus, o); }
      if (h == 0) { const float width = (plus + minus) * 1.02f + 1e-20f; const float rinv_ = fminf((float)NBIN / width, 60000.f); const _Float16 rvh = (_Float16)rinv_;
          RLO[wid * 8 + qw] = fminf(fmaxf(1024.f + minus * 1.02f * (float)rvh, 1024.f), 1535.f); RINV[wid * 8 + qw] = (float)rvh; } }
    f16x8 af[2][4], wa[4];
#pragma unroll
    for (int T = 0; T < 2; ++T) { const size_t qrow = rowbase + q0 + wid * 8 + 4 * T + (n32 >> 3);
#pragma unroll
        for (int ks = 0; ks < 4; ++ks) af[T][ks] = *(const f16x8*)(QIh + qrow * 512 + (n32 & 7) * 64 + 16 * ks + 8 * hi); }
    { const int m = n32; const f32x4 wv = (m < 8) ? *(const f32x4*)(WI + (rowbase + q0 + wid * 8 + m) * 8 + 4 * hi) : (f32x4){0.f, 0.f, 0.f, 0.f};
#pragma unroll
      for (int s = 0; s < 4; ++s) { f16x8 w8;
#pragma unroll
          for (int j = 0; j < 8; ++j) w8[j] = (_Float16)((m == 2 * s + (j >> 2)) ? wv[j & 3] : 0.f);
          wa[s] = w8; } }
    __syncthreads();
    f16x2 rv[2], nl[2];
#pragma unroll
    for (int p = 0; p < 2; ++p) { rv[p] = (f16x2){(_Float16)RINV[wid * 8 + 4 * hi + 2 * p], (_Float16)RINV[wid * 8 + 4 * hi + 2 * p + 1]}; nl[p] = (f16x2){(_Float16)RLO[wid * 8 + 4 * hi + 2 * p], (_Float16)RLO[wid * 8 + 4 * hi + 2 * p + 1]}; }
    unsigned long long* SCw = SCblk + wid * 64 + lane;
    idx_tiles<0>(c, NT, SCw, KIh, af, wa, rv, nl);
#ifdef PROBE_P0MODE
    idx_tiles<0, PROBE_P0MODE>(c, NT, SCw, KIh, af, wa, rv, nl);
#endif
    asm volatile("s_waitcnt vmcnt(0)" ::: "memory");
    idx_boundary(c);
    __syncthreads();
    { LAS u32x4* z = (LAS u32x4*)((LAS unsigned*)(c.lds + X_CAND) + wid * 8 * CAP);
#pragma unroll
      for (int j = 0; j < 3; ++j) z[lane + 64 * j] = (u32x4){0u, 0u, 0u, 0u}; }
    unsigned thi[8], tlo[8];
    { const int rr = (lane >> 1) & 7, rowl = wid * 8 + rr; const _Float16 nl_ = (_Float16)RLO[rowl], rv_ = (_Float16)RINV[rowl]; const int target = RBST[rowl] - (lane & 1);
      int lo = 0x03FF, hi_ = 0xFC00;
#pragma unroll 1
      for (int it = 0; it < 16; ++it) { const int mid = (lo + hi_) >> 1; const unsigned hbm = (mid & 0x8000) ? (unsigned)(mid ^ 0x8000) : (~(unsigned)mid & 0xFFFFu);
          const bool up = idx_bin(hbm, rv_, nl_) > target; hi_ = up ? mid : hi_; lo = up ? lo : mid; }
      const unsigned T = (hi_ & 0x8000) ? (unsigned)(hi_ ^ 0x8000) : (~(unsigned)hi_ & 0xFFFFu);
#pragma unroll
      for (int r = 0; r < 8; ++r) { thi[r] = __builtin_amdgcn_readlane(T, 2 * r); tlo[r] = __builtin_amdgcn_readlane(T, 2 * r + 1); } }
    idx_emit(c, NT, SCblk, thi, tlo);
#ifdef PROBE_EMIT2
    idx_emit(c, NT, SCblk, thi, tlo);
#endif
    asm volatile("s_waitcnt lgkmcnt(0)" ::: "memory");
    {
        LAS unsigned short* LIST = (LAS unsigned short*)(c.lds + X_BM); LAS int* CABV = (LAS int*)(c.lds + X_RED) + 128;
        const int r = lane >> 3, g = lane & 7, rowl = wid * 8 + r;
        int nc = CCNT[rowl]; nc = nc > CAP ? CAP : nc; const int need = RNEED[rowl], na = CABV[rowl];
        int ncmax = nc;
#pragma unroll
        for (int o = 8; o < 64; o <<= 1) ncmax = max(ncmax, __shfl_xor(ncmax, o));
        ncmax = __builtin_amdgcn_readfirstlane(ncmax);
        const LAS unsigned* cs = (const LAS unsigned*)(c.lds + X_CAND) + rowl * CAP;
#pragma unroll 1
        for (int i0 = 0; i0 < ncmax; i0 += 8) { const int i = i0 + g; const bool have = i < nc; const unsigned ci = cs[i]; int rank = 0;
#pragma unroll 1
            for (int k0 = 0; k0 < ncmax; k0 += 8) { const u32x4 ka = *(const LAS u32x4*)(cs + k0), kb = *(const LAS u32x4*)(cs + k0 + 4);
                rank += (int)(ka.x > ci) + (int)(ka.y > ci) + (int)(ka.z > ci) + (int)(ka.w > ci) + (int)(kb.x > ci) + (int)(kb.y > ci) + (int)(kb.z > ci) + (int)(kb.w > ci); }
            const int p = na + rank;
            if (have && rank < need && p < 256) LIST[rowl * 256 + p] = (unsigned short)(0xFFFFu - (ci & 0xFFFFu)); }
        asm volatile("s_waitcnt lgkmcnt(0)" ::: "memory");
        const LAS u32x4* src = (const LAS u32x4*)(LIST + wid * 8 * 256) + lane * 4; u32x4* dst = (u32x4*)(SEL + (rowbase + q0 + wid * 8) * 256) + lane * 4;
#pragma unroll
        for (int k = 0; k < 4; ++k) dst[k] = src[k];
    }
    asm volatile("s_waitcnt vmcnt(0) lgkmcnt(0)\n\ts_barrier" ::: "memory");
}

typedef short s16x4v __attribute__((ext_vector_type(4)));
constexpr int A_BUF = 0, A_SEL = 65536, A_BKB = 65536 + 4096, A_BKT = 65536 + 8192, A_RB = A_BKT + 8192, A_END = A_RB + 2048 + 64;
__device__ __forceinline__ void dsa_tables(const Ctx& c, const float* relb) {
    LAS unsigned char* BK = c.lds + A_BKT; LAS float* RB = (LAS float*)(c.lds + A_RB);
    for (int i = c.tid; i < 8192; i += 512) BK[i] = (unsigned char)(int)att::t5_bucket_f(i);
    RB[c.tid] = relb[c.tid] * LOG2E; if (c.tid < 16) RB[512 + c.tid] = -INFINITY;
    __syncthreads();
}
__device__ __forceinline__ int swz(int row) { return 2 * (row & 7) + ((row >> 3) & 1); }
__device__ __forceinline__ void dsa_query(const Ctx& c, int tok, const unsigned char* QPU, unsigned char* UO, const unsigned char* CKVN, const unsigned short* SEL) {
    int lane = c.lane; asm volatile("" : "+v"(lane));
    const int wid = c.wave, l15 = lane & 15, kq = lane >> 4;
    const int b = tok / SEQ, q = tok - b * SEQ; const size_t rowbase = (size_t)b * SEQ;
    const int nsel = (q + 1 < 256) ? q + 1 : 256, nch = (nsel + 15) >> 4;
    const unsigned lds0 = (unsigned)(size_t)c.lds;
    LAS unsigned char* buf = c.lds + A_BUF + wid * 8192; const unsigned buf0 = lds0 + A_BUF + wid * 8192;
    LAS unsigned short* lsel = (LAS unsigned short*)(c.lds + A_SEL + wid * 512);
    LAS unsigned char* lbk = c.lds + A_BKB + wid * 256;
    const LAS unsigned char* BK = c.lds + A_BKT; const LAS float* RB = (const LAS float*)(c.lds + A_RB);
    asm volatile("s_waitcnt lgkmcnt(0)" ::: "memory");
    { const u32x2 v = __builtin_nontemporal_load((const u32x2*)(SEL + (size_t)tok * 256) + lane); *((LAS u32x2*)lsel + lane) = v;
      unsigned bw = 0;
#pragma unroll
      for (int i = 0; i < 4; ++i) { const int e = 4 * lane + i; const int key = (int)(((i < 2) ? v.x : v.y) >> (16 * (i & 1))) & 0xffff; const int dist = q - key; const unsigned bk = (e < nsel && dist >= 0) ? (unsigned)BK[dist] : 32u; bw |= bk << (8 * i); }
      *((LAS unsigned*)lbk + lane) = bw; }
    bf16x8 qf[8];
#pragma unroll
    for (int ks = 0; ks < 8; ++ks) { const u32x2 w = __builtin_nontemporal_load((const u32x2*)(QPU + (size_t)tok * 4096 + l15 * 256 + 64 * (ks >> 1) + 16 * kq + 8 * (ks & 1)));
        const f32x2 a0 = __builtin_amdgcn_cvt_pk_f32_fp8((int)w.x, false), a1 = __builtin_amdgcn_cvt_pk_f32_fp8((int)w.x, true), a2 = __builtin_amdgcn_cvt_pk_f32_fp8((int)w.y, false), a3 = __builtin_amdgcn_cvt_pk_f32_fp8((int)w.y, true);
        u32x4 q4; q4.x = att::cvtpk(a0.x, a0.y); q4.y = att::cvtpk(a1.x, a1.y); q4.z = att::cvtpk(a2.x, a2.y); q4.w = att::cvtpk(a3.x, a3.y); qf[ks] = __builtin_bit_cast(bf16x8, q4); }
    asm volatile("s_waitcnt lgkmcnt(0)" ::: "memory");
#define DSA_SELROW(ch) ({ int e_ = 16 * (ch) + l15; e_ = e_ < nsel ? e_ : 0; (unsigned)lsel[e_]; })
#define DSA_LOADROW(R, row) do { const unsigned char* rp_ = CKVN + (rowbase + (row)) * 256 + 16 * kq; \
        _Pragma("unroll") for (int ksp = 0; ksp < 4; ++ksp) R[ksp] = *(const u32x4*)(rp_ + 64 * ksp); } while (0)
#define DSA_LOAD(R, ch) DSA_LOADROW(R, DSA_SELROW(ch))
    typedef __bf16 bf2_t __attribute__((ext_vector_type(2)));
#define DSA_CVT(w_, sel_) __builtin_bit_cast(unsigned, __builtin_amdgcn_cvt_scalef32_pk_bf16_fp8((int)(w_), 1.0f, sel_))
    u32x4 R0[4], R1[4], R2[4];
    DSA_LOAD(R0, 0); DSA_LOAD(R1, 1); DSA_LOAD(R2, 2);
    unsigned seln = DSA_SELROW(3), bwn = *((const LAS unsigned*)lbk + kq);
    float m_run = -INFINITY, l_run = 0.f;
    f32x4 o[16];
#pragma unroll
    for (int ct = 0; ct < 16; ++ct) o[ct] = (f32x4){0.f, 0.f, 0.f, 0.f};
    const int wrow = l15 * 512, wsw = swz(l15);
    const int trow = 4 * kq + ((lane & 15) >> 2), tsw = swz(trow);
    const int tbase = (int)buf0 + trow * 512 + (lane & 1) * 8;
#define DSA_CHUNK(R, ch, LOADC) do { f32x4 s; float rbv[4]; \
        { const unsigned bw = bwn; if ((ch) + 1 < 16) bwn = *((const LAS unsigned*)lbk + 4 * ((ch) + 1) + kq);              \
          _Pragma("unroll") for (int i = 0; i < 4; ++i) rbv[i] = RB[((bw >> (8 * i)) & 0xffu) * 16 + l15]; } \
        __builtin_amdgcn_sched_barrier(0); { \
        bf16x8 a_[8]; \
        _Pragma("unroll") for (int ksp = 0; ksp < 4; ++ksp) { const u32x4 r_ = R[ksp]; \
            a_[2 * ksp] = __builtin_bit_cast(bf16x8, (u32x4){DSA_CVT(r_.x, false), DSA_CVT(r_.x, true), DSA_CVT(r_.y, false), DSA_CVT(r_.y, true)}); \
            a_[2 * ksp + 1] = __builtin_bit_cast(bf16x8, (u32x4){DSA_CVT(r_.z, false), DSA_CVT(r_.z, true), DSA_CVT(r_.w, false), DSA_CVT(r_.w, true)}); } \
        __builtin_amdgcn_sched_barrier(0); if (LOADC) { DSA_LOADROW(R, seln); if ((ch) + 4 < 16) seln = DSA_SELROW((ch) + 4); }            \
        f32x4 s0 = (f32x4){0.f, 0.f, 0.f, 0.f}, s1 = (f32x4){0.f, 0.f, 0.f, 0.f}; \
        _Pragma("unroll") for (int ks = 0; ks < 8; ks += 2) { s0 = __builtin_amdgcn_mfma_f32_16x16x32_bf16(a_[ks], qf[ks], s0, 0, 0, 0); s1 = __builtin_amdgcn_mfma_f32_16x16x32_bf16(a_[ks + 1], qf[ks + 1], s1, 0, 0, 0); } \
        _Pragma("unroll") for (int ks = 0; ks < 8; ++ks) *(LAS bf16x8*)(buf + wrow + ((((8 * (ks >> 1) + 2 * kq + (ks & 1))) ^ wsw) * 16)) = a_[ks]; \
        s = (s0 + s1) * (1.0f / (FP8_SQ * FP8_SCK)); } \
        float mx = -INFINITY; \
        _Pragma("unroll") for (int i = 0; i < 4; ++i) { s[i] += rbv[i]; mx = fmaxf(mx, s[i]); } \
        { auto r16_ = __builtin_amdgcn_permlane16_swap(__float_as_uint(mx), __float_as_uint(mx), false, false); mx = fmaxf(__uint_as_float(r16_[0]), __uint_as_float(r16_[1])); } mx = att::half_swap_max(mx);            \
        const float mnew = (mx > m_run + 8.0f) ? mx : m_run, alpha = __builtin_amdgcn_exp2f(m_run - mnew);            \
        m_run = mnew; \
        float p[4]; \
        _Pragma("unroll") for (int i = 0; i < 4; ++i) p[i] = __builtin_amdgcn_exp2f(s[i] - mnew); \
        l_run = l_run * alpha + (p[0] + p[1]) + (p[2] + p[3]); \
        if (__any(alpha != 1.0f)) {            \
            float a4[4]; \
            _Pragma("unroll") for (int i = 0; i < 4; ++i) a4[i] = __shfl(alpha, 4 * kq + i); \
            _Pragma("unroll") for (int ct = 0; ct < 16; ++ct) { o[ct][0] *= a4[0]; o[ct][1] *= a4[1]; o[ct][2] *= a4[2]; o[ct][3] *= a4[3]; } \
        } \
        u32x2 pw; pw.x = att::cvtpk(p[0], p[1]); pw.y = att::cvtpk(p[2], p[3]); \
        const s16x4v pa = __builtin_bit_cast(s16x4v, pw); \
          \
        _Pragma("unroll") for (int c8 = 0; c8 < 2; ++c8) { s16x4v bv[8]; \
            _Pragma("unroll") for (int u = 0; u < 8; ++u) { const int ct = 8 * c8 + u; const int addr = tbase + ((((2 * ct + ((lane & 3) >> 1))) ^ tsw) * 16); asm volatile("ds_read_b64_tr_b16 %0,%1" : "=v"(bv[u]) : "v"(addr) : "memory"); } \
            asm volatile("s_waitcnt lgkmcnt(0)" ::: "memory"); __builtin_amdgcn_sched_barrier(0); \
            _Pragma("unroll") for (int u = 0; u < 8; ++u) o[8 * c8 + u] = __builtin_amdgcn_mfma_f32_16x16x16bf16_1k(pa, bv[u], o[8 * c8 + u], 0, 0, 0); } \
    } while (0)
#pragma unroll 1
    for (int ch = 0; ch < 12; ch += 3) { DSA_CHUNK(R0, ch, true); DSA_CHUNK(R1, ch + 1, true); DSA_CHUNK(R2, ch + 2, true); }
    DSA_CHUNK(R0, 12, true); DSA_CHUNK(R1, 13, false); DSA_CHUNK(R2, 14, false); DSA_CHUNK(R0, 15, false);
#undef DSA_LOAD
#undef DSA_LOADROW
#undef DSA_SELROW
#undef DSA_CHUNK
#undef DSA_CVT
    float lt = l_run; lt += __shfl_xor(lt, 16); lt += __shfl_xor(lt, 32);
    const float rl = 1.0f / lt; float r4[4];
#pragma unroll
    for (int i = 0; i < 4; ++i) r4[i] = __shfl(rl, 4 * kq + i);
    LAS unsigned char* stg = buf;
    asm volatile("s_waitcnt lgkmcnt(0)" ::: "memory");
#pragma unroll
    for (int ct = 0; ct < 16; ++ct)
#pragma unroll
        for (int i = 0; i < 4; ++i) stg[(4 * kq + i) * 256 + 16 * ct + l15] = to_fp8(o[ct][i] * (r4[i] * (FP8_SU / FP8_SCK)));
    asm volatile("s_waitcnt lgkmcnt(0)" ::: "memory");
#pragma unroll
    for (int i = 0; i < 4; ++i) { const u32x4 v = *((const LAS u32x4*)stg + i * 64 + lane); __builtin_nontemporal_store(v, (u32x4*)(UO + (size_t)tok * 4096) + i * 64 + lane); }
    asm volatile("s_waitcnt lgkmcnt(0)" ::: "memory");
}
}
#ifndef ONE_LAUNCH
#define ONE_LAUNCH 0
#endif
constexpr int NPHASE = 17;
typedef const __attribute__((address_space(4))) Args* KArgPtr;
#if defined(__HIP_DEVICE_COMPILE__)
#define PHASE_ARGS_LOAD(a) KArgPtr ap_ = (KArgPtr)__builtin_amdgcn_kernarg_segment_ptr(); asm volatile("" : "+s"(ap_)); const Args a = *ap_
#else
#define PHASE_ARGS_LOAD(a) const Args a = a0
#endif
#define PHASE_ARGS(a) PHASE_ARGS_LOAD(a); Ctx c = c0; { int l_ = (int)__builtin_amdgcn_mbcnt_hi(~0u, __builtin_amdgcn_mbcnt_lo(~0u, 0u)); asm volatile("" : "+v"(l_)); c.lane = l_; c.tid = c0.wave * 64 + l_; } \
    unsigned* const ctl = (unsigned*)(a.ws + WS_CTL); float* const X = a.out; const float* const MODS0 = (const float*)(a.ws + WS_MODS); const float* const MODS1 = MODS0 + 4 * 6144; bf16_t* const Hb = (bf16_t*)(a.ws + WS_H); bf16_t* const X16 = (bf16_t*)(a.ws + WS_X16); \
    (void)ctl; (void)X; (void)MODS0; (void)MODS1; (void)Hb; (void)X16
__global__ void __launch_bounds__(512, 2) mk_fwd(Args a0) {
    extern __shared__ __attribute__((aligned(16))) unsigned char lds_[];
    Ctx c0; c0.lds = (LAS unsigned char*)lds_; c0.tid = threadIdx.x; c0.lane = c0.tid & 63; c0.wave = __builtin_amdgcn_readfirstlane(c0.tid >> 6);
    c0.G = gridDim.x; { const int bx = blockIdx.x; c0.vcu = (c0.G % 8 == 0) ? (bx % 8) * (c0.G / 8) + bx / 8 : bx; }
    volatile LAS unsigned* MISC = (volatile LAS unsigned*)(c0.lds + MISC_OFF);
    if (c0.tid < 64) MISC[c0.tid] = 0u;
    __syncthreads();
    XcdBarrier bar; bar.bar = (unsigned*)(a0.ws + WS_CTL) + CW_BAR; bar.x = 0; bar.st = MISC + 8;
    if (a0.ph_hi - a0.ph_lo > 1) bar = xcd_barrier_post(bar.bar, MISC + 8, c0.tid == 0);
    const int lo = a0.ph_lo, hi = a0.ph_hi;
#if defined(PH_ONLY)
#define IN(k) ((k) == PH_ONLY)
#elif defined(PH_MASK)
#define IN(k) (((PH_MASK >> (k)) & 1) && lo <= (k) && (k) < hi)
#else
#define IN(k) (lo <= (k) && (k) < hi)
#endif
#ifndef REP_MASK
#define REP_MASK 0
#endif
#define PH(k) if (IN(k))
#define SEAM(k) do { if (IN(k) && IN((k) + 1)) xcd_barrier(bar, c0.wave == 0 && __builtin_amdgcn_mbcnt_hi(~0u, __builtin_amdgcn_mbcnt_lo(~0u, 0u)) == 0u); } while (0)

#ifdef CALIB_A
    { PHASE_ARGS(a); if (lo == 0) { ThinArgs t{}; t.src = a.in[I_X]; t.nw = a.in[I_FN]; t.fdst = a.out; thin_pass<false, 0, false, true, false>(c, a, t); } return; }
#endif
    PH(0) { PHASE_ARGS(a); p0_prologue(c, a); }
#if (REP_MASK >> 0) & 1
    __syncthreads();
    PH(0) { PHASE_ARGS(a); p0_prologue(c, a); }
#endif
    SEAM(0);
    PH(1) {
        PHASE_ARGS(a); ThinArgs t{}; t.src = a.in[I_X]; t.xdst = X; t.nw = a.in[I_L0N1]; t.mods = MODS0; t.sh_off = 0; t.hdst = Hb; t.w8 = a.in[I_L0WIN] + 1536; t.w8ld = EVEN_IN; t.fb = a.in[I_L0FB]; t.e8dst = (float*)(a.ws + WS_LF);
        thin_pass<false, 1, false, false, false>(c, a, t);
    }
    SEAM(1);
    PH(2) {
        PHASE_ARGS(a);
        if (blockIdx.x < 32) att::fox_scan(c, (const float*)(a.ws + WS_LF), (float*)(a.ws + WS_KB2), blockIdx.x);
        DenseSched S{(const char*)(a.ws + WS_BT0), DM / 2, 15, 128 * 15, c.G, c.vcu}; EpiBf16Plain E{(bf16_t*)(a.ws + WS_QKV0), QKV0_LD, 1.0f / (FP8_SH * FP8_SW0)};
        pg8::gemm_phase<EpiBf16Plain, DenseSched, true, true>(c.lds, c.tid, Hb, DM, DM, S, E);
    }
#if (REP_MASK >> 2) & 1
    __syncthreads();
    PH(2) {
        PHASE_ARGS(a);
        if (blockIdx.x < 32) att::fox_scan(c, (const float*)(a.ws + WS_LF), (float*)(a.ws + WS_KB2), blockIdx.x);
        DenseSched S{(const char*)(a.ws + WS_BT0), DM / 2, 15, 128 * 15, c.G, c.vcu}; EpiBf16Plain E{(bf16_t*)(a.ws + WS_QKV0), QKV0_LD, 1.0f / (FP8_SH * FP8_SW0)};
        pg8::gemm_phase<EpiBf16Plain, DenseSched, true, true>(c.lds, c.tid, Hb, DM, DM, S, E);
    }
#endif
    SEAM(2);
    PH(3) {
        PHASE_ARGS(a);
        const bf16_t* QKV = (const bf16_t*)(a.ws + WS_QKV0); bf16_t* MER = (bf16_t*)(a.ws + WS_MER);
        for (int v = c.vcu; v < 256; v += c.G) { const int bh = v >> 3, s = v & 7;
            float kmaxn;
            { const bf16_t* Kh = QKV + (size_t)(bh >> 3) * SEQ * QKV0_LD + 512 + (bh & 7) * 64; float m2 = 0.f;
#pragma unroll 1
              for (int k = c.tid; k < SEQ; k += 512) { const u32x4* kp = (const u32x4*)(Kh + (size_t)k * QKV0_LD); float s2 = 0.f;
#pragma unroll
                  for (int i = 0; i < 8; ++i) { const u32x4 w_ = kp[i];
#pragma unroll
                      for (int e = 0; e < 4; ++e) { const float lo_ = __builtin_bit_cast(float, w_[e] << 16), hi_ = __builtin_bit_cast(float, w_[e] & 0xffff0000u); s2 += lo_ * lo_ + hi_ * hi_; } }
                  m2 = fmaxf(m2, s2); }
#pragma unroll
              for (int o_ = 1; o_ < 64; o_ <<= 1) m2 = fmaxf(m2, __shfl_xor(m2, o_));
              LAS float* km = (LAS float*)(c.lds + att::F_WS + 2048 + 64);
              if (c.lane == 0) km[c.wave] = m2;
              __syncthreads();
              m2 = km[0];
#pragma unroll
              for (int w_ = 1; w_ < 8; ++w_) m2 = fmaxf(m2, km[w_]);
              kmaxn = sqrtf(m2); __syncthreads(); }
#pragma unroll 1
            for (int i = 0; i < 4; ++i) { const int qb = (i == 0) ? s : (i == 1) ? 15 - s : (i == 2) ? 16 + s : 31 - s; att::fox_unit(c, bh >> 3, bh & 7, qb, QKV, (const float*)(a.ws + WS_KB2), MER, kmaxn); } }
#ifdef PROBE_FOX2
        for (int v = c.vcu; v < 256; v += c.G) { const int bh = v >> 3, s = v & 7;
#pragma unroll 1
            for (int i = 0; i < 4; ++i) { const int qb = (i == 0) ? s : (i == 1) ? 15 - s : (i == 2) ? 16 + s : 31 - s; att::fox_unit(c, bh >> 3, bh & 7, qb, QKV, (const float*)(a.ws + WS_KB2), MER, 1e30f); } }
#endif
        att::dil_tables(c, a.in[I_RELB]);
        { unsigned* dq = ctl + 8192;
#pragma unroll 1
          for (;;) { unsigned u = 0; if (c.lane == 0) u = __hip_atomic_fetch_add(dq, 1u, __ATOMIC_RELAXED, __HIP_MEMORY_SCOPE_AGENT); u = __builtin_amdgcn_readfirstlane(u); if (u >= 4096u) break;
            att::dil_unit(c, (int)u, QKV, MER);
#ifdef CONV_IN_P3
            asm volatile("s_waitcnt vmcnt(0) lgkmcnt(0)" ::: "memory");
#pragma unroll 1
            for (int k = 0; k < 12; ++k) { int ln_ = c.lane; asm volatile("" : "+v"(ln_)); convert_moe_item(12 * (int)u + k, ln_, a.in[I_L0W1], a.in[I_L0W2], a.ws + WS_W1T, a.ws + WS_W2T, (LAS float*)(c.lds + att::D_TILE + c.wave * 16384)); }
#endif
          } }
#ifdef PROBE_DIL2
        __syncthreads();
#pragma unroll 1
        for (int u = c.vcu * 8 + c.wave; u < 4096; u += c.G * 8) att::dil_unit(c, u, QKV, MER);
#endif
    }
#if (REP_MASK >> 3) & 1
    __syncthreads();
    PH(3) {
        PHASE_ARGS(a);
        const bf16_t* QKV = (const bf16_t*)(a.ws + WS_QKV0); bf16_t* MER = (bf16_t*)(a.ws + WS_MER);
        for (int v = c.vcu; v < 256; v += c.G) { const int bh = v >> 3, s = v & 7;
#pragma unroll 1
            for (int i = 0; i < 4; ++i) { const int qb = (i == 0) ? s : (i == 1) ? 15 - s : (i == 2) ? 16 + s : 31 - s; att::fox_unit(c, bh >> 3, bh & 7, qb, QKV, (const float*)(a.ws + WS_KB2), MER, 1e30f); } }
        att::dil_tables(c, a.in[I_RELB]);
#pragma unroll 1
        for (int u = c.vcu * 8 + c.wave; u < 4096; u += c.G * 8) att::dil_unit(c, u, QKV, MER);
    }
#endif
    SEAM(3);
    PH(4) {
        PHASE_ARGS(a); DenseSched S{(const char*)(a.ws + WS_WO0), MER_LD, 4, 128 * 4, c.G, c.vcu}; EpiResid<false, true> E{a.in[I_X], X16, MODS0 + 2048, 1.0f};
        pg8::gemm_phase<EpiResid<false, true>, DenseSched, true>(c.lds, c.tid, (const bf16_t*)(a.ws + WS_MER), MER_LD, MER_LD, S, E);
    }
#if (REP_MASK >> 4) & 1
    __syncthreads();
    PH(4) {
        PHASE_ARGS(a); DenseSched S{(const char*)(a.ws + WS_WO0), MER_LD, 4, 128 * 4, c.G, c.vcu}; EpiResid<false, true> E{a.in[I_X], X16, MODS0 + 2048, 1.0f};
        pg8::gemm_phase<EpiResid<false, true>, DenseSched, true>(c.lds, c.tid, (const bf16_t*)(a.ws + WS_MER), MER_LD, MER_LD, S, E);
    }
#endif
    SEAM(4);
#define ROUTER_PHASE(P, L, NW, RWI, RBI, MODS) PH(P) { PHASE_ARGS(a); ThinArgs t{}; t.src = (const float*)X16; t.nw = a.in[NW]; t.mods = MODS; t.sh_off = 3072; t.hdst = Hb; t.rw = a.in[RWI]; t.rb = a.in[RBI]; t.layer = L; \
        thin_pass<false, 0, true, false, false, true, false>(c, a, t); }
#define MOE1_PHASE(P, L, B1I) PH(P) { PHASE_ARGS(a); moe_tables(c, ctl, L); MoeSched<8, true> S{(const LAS int*)(c.lds + MOE_TS), (const LAS int*)(c.lds + MOE_TS) + 64, (const int*)(a.ws + WS_TOK), (const char*)(a.ws + WS_W1T), c.G, c.vcu, __builtin_amdgcn_readfirstlane(((const LAS int*)(c.lds + MOE_TS))[32])}; \
        EpiSwiglu E{a.ws + WS_ACT, a.in[B1I]}; pg8::gemm_phase<EpiSwiglu, MoeSched<8, true>, true, true>(c.lds, c.tid, Hb, DM, DM, S, E); }
#define MOE2_PHASE(P, L, B2I) PH(P) { PHASE_ARGS(a); moe_tables(c, ctl, L); MoeSched<4, false> S{(const LAS int*)(c.lds + MOE_TS), (const LAS int*)(c.lds + MOE_TS) + 64, nullptr, (const char*)(a.ws + WS_W2T), c.G, c.vcu, __builtin_amdgcn_readfirstlane(((const LAS int*)(c.lds + MOE_TS))[32])}; \
        EpiBiasBf16 E{a.ws + WS_Y, a.in[B2I]}; pg8::gemm_phase<EpiBiasBf16, MoeSched<4, false>, true, true>(c.lds, c.tid, (const bf16_t*)(a.ws + WS_ACT), DEXP, DEXP, S, E); }
    ROUTER_PHASE(5, 0, I_L0N2, I_L0RW, I_L0RB, MODS0)
    SEAM(5);
    MOE1_PHASE(6, 0, I_L0B1)
#if (REP_MASK >> 6) & 1
    __syncthreads();
    MOE1_PHASE(6, 0, I_L0B1)
#endif
    SEAM(6);
    MOE2_PHASE(7, 0, I_L0B2)
#ifdef PROBE_P7NOEPI
    __syncthreads();
    PH(7) { PHASE_ARGS(a); moe_tables(c, ctl, 0); MoeSched<4, false> S{(const LAS int*)(c.lds + MOE_TS), (const LAS int*)(c.lds + MOE_TS) + 64, nullptr, (const char*)(a.ws + WS_W2T), c.G, c.vcu, __builtin_amdgcn_readfirstlane(((const LAS int*)(c.lds + MOE_TS))[32])};
        EpiNone E{}; pg8::gemm_phase<EpiNone, MoeSched<4, false>, true, true>(c.lds, c.tid, (const bf16_t*)(a.ws + WS_ACT), DEXP, DEXP, S, E); }
#endif
#if (REP_MASK >> 7) & 1
    __syncthreads();
    MOE2_PHASE(7, 0, I_L0B2)
#endif
    SEAM(7);
#ifdef PROBE_T8
    PH(8) { PHASE_ARGS(a); ThinArgs t{}; t.src = X; t.xdst = (float*)(a.ws + WS_R1 + 136 * MiB); t.nw = a.in[I_L1N1]; t.mods = MODS1; t.sh_off = 0; t.cmods = MODS0; t.hdst = (bf16_t*)(a.ws + 96 * MiB); t.w8 = a.in[I_L1WIN] + 1856; t.w8ld = ODD_IN; t.e8dst = (float*)(a.ws + 191 * MiB); t.h8dst = a.ws + 192 * MiB; t.layer = 0; t.Y = a.ws + WS_Y;
        thin_pass<true, 2, false, false, false>(c, a, t); __syncthreads(); }
#endif
    PH(8) {
        PHASE_ARGS(a); ThinArgs t{}; t.src = (const float*)X16; t.xdst = (float*)X16; t.nw = a.in[I_L1N1]; t.mods = MODS1; t.sh_off = 0; t.cmods = MODS0; t.hdst = Hb; t.w8 = a.in[I_L1WIN] + 1856; t.w8ld = ODD_IN; t.e8dst = (float*)(a.ws + WS_WI); t.h8dst = a.ws + WS_H8; t.layer = 0; t.Y = a.ws + WS_Y;
        thin_pass<true, 2, false, false, false, true, true>(c, a, t);
        __syncthreads();
#ifndef CONV_IN_P11
        convert_moe_weights(c, a.in[I_L1W1], a.in[I_L1W2], a.ws + WS_W1T, a.ws + WS_W2T, (LAS float*)(c.lds + c.wave * 8704));
#endif
#ifdef PROBE_CONV2
        convert_moe_weights(c, a.in[I_L1W1], a.in[I_L1W2], a.ws + WS_W1T, a.ws + WS_W2T, (LAS float*)(c.lds + c.wave * 8704));
#endif
    }
    SEAM(8);
    PH(9) {
        PHASE_ARGS(a);
        { DenseSched S{(const char*)(a.ws + WS_BT1), DM / 2, 16, 128 * 16, c.G, c.vcu}; EpiFp8Plain E{a.ws + WS_QP, 4096, FP8_SQ / (FP8_SH * FP8_SQP)};
          pg8::gemm_phase<EpiFp8Plain, DenseSched, true, true>(c.lds, c.tid, (const bf16_t*)(a.ws + WS_H8), DM, DM, S, E); }
        { DenseSched S{(const char*)(a.ws + WS_BT1) + (size_t)4096 * 1024 * 2, DM, 4, 128 * 4, c.G, c.vcu};
          EpiL1Proj E{(bf16_t*)(a.ws + WS_QP), (bf16_t*)(a.ws + WS_CKV), (bf16_t*)(a.ws + WS_QI), (bf16_t*)(a.ws + WS_KI)};
          pg8::gemm_phase<EpiL1Proj, DenseSched, true>(c.lds, c.tid, Hb, DM, DM, S, E); }
    }
#if (REP_MASK >> 9) & 1
    __syncthreads();
    PH(9) {
        PHASE_ARGS(a);
        { DenseSched S{(const char*)(a.ws + WS_BT1), DM / 2, 16, 128 * 16, c.G, c.vcu}; EpiFp8Plain E{a.ws + WS_QP, 4096, FP8_SQ / (FP8_SH * FP8_SQP)};
          pg8::gemm_phase<EpiFp8Plain, DenseSched, true, true>(c.lds, c.tid, (const bf16_t*)(a.ws + WS_H8), DM, DM, S, E); }
        { DenseSched S{(const char*)(a.ws + WS_BT1) + (size_t)4096 * 1024 * 2, DM, 4, 128 * 4, c.G, c.vcu};
          EpiL1Proj E{(bf16_t*)(a.ws + WS_QP), (bf16_t*)(a.ws + WS_CKV), (bf16_t*)(a.ws + WS_QI), (bf16_t*)(a.ws + WS_KI)};
          pg8::gemm_phase<EpiL1Proj, DenseSched, true>(c.lds, c.tid, Hb, DM, DM, S, E); }
    }
#endif
    SEAM(9);
    PH(10) {
        PHASE_ARGS(a);
        dsa::ckv_norm(c, (const bf16_t*)(a.ws + WS_CKV), a.in[I_L1KVN], a.ws + WS_CKVN);
        for (int v = c.vcu; v < 256; v += c.G) { const int b = v >> 6, p = v & 63;
#pragma unroll 1
            for (int u = 0; u < 2; ++u) dsa::idx_unit(c, b, u ? 127 - p : p, (const bf16_t*)(a.ws + WS_QI), (const bf16_t*)(a.ws + WS_KI), (const float*)(a.ws + WS_WI), (unsigned short*)(a.ws + WS_SEL),
                (unsigned long long*)(a.ws + (blockIdx.x < 128 ? WS_R1 + 128 * MiB : WS_R1 + 468 * MiB) + (size_t)(blockIdx.x & 127) * MiB)); }
    }
#if (REP_MASK >> 10) & 1
    __syncthreads();
    PH(10) {
        PHASE_ARGS(a);
        dsa::ckv_norm(c, (const bf16_t*)(a.ws + WS_CKV), a.in[I_L1KVN], a.ws + WS_CKVN);
        for (int v = c.vcu; v < 256; v += c.G) { const int b = v >> 6, p = v & 63;
#pragma unroll 1
            for (int u = 0; u < 2; ++u) dsa::idx_unit(c, b, u ? 127 - p : p, (const bf16_t*)(a.ws + WS_QI), (const bf16_t*)(a.ws + WS_KI), (const float*)(a.ws + WS_WI), (unsigned short*)(a.ws + WS_SEL),
                (unsigned long long*)(a.ws + (blockIdx.x < 128 ? WS_R1 + 128 * MiB : WS_R1 + 468 * MiB) + (size_t)(blockIdx.x & 127) * MiB)); }
    }
#endif
    SEAM(10);
    PH(11) {
        PHASE_ARGS(a);
        dsa::dsa_tables(c, a.in[I_RELB]);
#ifdef CONV_IN_P11
        LAS float* cscr = (LAS float*)(c.lds + dsa::A_END + c.wave * 8704); int cit = c.vcu * 8 + c.wave; const int cstep = c.G * 8; int par = 0;
#endif
#pragma unroll 1
        for (int tok = c.vcu * 8 + c.wave; tok < NTOK; tok += c.G * 8) { dsa::dsa_query(c, tok, a.ws + WS_QP, a.ws + WS_U, a.ws + WS_CKVN, (const unsigned short*)(a.ws + WS_SEL));
#ifdef CONV_IN_P11
#pragma unroll 1
            for (int k = 0; k < 1 + par; ++k) { int ln_ = c.lane; asm volatile("" : "+v"(ln_)); if (cit < NEXP * (16 * 64 + 16 * 32)) convert_moe_item(cit, ln_, a.in[I_L1W1], a.in[I_L1W2], a.ws + WS_W1T, a.ws + WS_W2T, cscr); cit += cstep; }
            par ^= 1;
#endif
        }
#ifdef CONV_IN_P11
#pragma unroll 1
        for (; cit < NEXP * (16 * 64 + 16 * 32); cit += cstep) convert_moe_item(cit, c.lane, a.in[I_L1W1], a.in[I_L1W2], a.ws + WS_W1T, a.ws + WS_W2T, cscr);
#endif
    }
#if (REP_MASK >> 11) & 1
    __syncthreads();
    PH(11) {
        PHASE_ARGS(a);
        dsa::dsa_tables(c, a.in[I_RELB]);
#pragma unroll 1
        for (int tok = c.vcu * 8 + c.wave; tok < NTOK; tok += c.G * 8) dsa::dsa_query(c, tok, a.ws + WS_QP, a.ws + WS_U, a.ws + WS_CKVN, (const unsigned short*)(a.ws + WS_SEL));
    }
#endif
    SEAM(11);
#ifdef PROBE_P12
    PH(12) { PHASE_ARGS(a); DenseSched S{(const char*)(a.ws + WS_WC1), 4096 / 2, 4, 128 * 4, c.G, c.vcu}; EpiResid E{X, (float*)(a.ws + WS_R1), MODS1 + 2048, 1.0f / (FP8_SU * FP8_SWC)};
        pg8::gemm_phase<EpiResid, DenseSched, true, true>(c.lds, c.tid, (const bf16_t*)(a.ws + WS_U), 4096, 4096, S, E); __syncthreads(); }
#endif
    PH(12) {
        PHASE_ARGS(a); DenseSched S{(const char*)(a.ws + WS_WC1), 4096 / 2, 4, 128 * 4, c.G, c.vcu}; EpiResid<true, true> E{X16, X16, MODS1 + 2048, 1.0f / (FP8_SU * FP8_SWC)};
        pg8::gemm_phase<EpiResid<true, true>, DenseSched, true, true>(c.lds, c.tid, (const bf16_t*)(a.ws + WS_U), 4096, 4096, S, E);
    }
    SEAM(12);
#ifdef PROBE_T13
    PH(13) { PHASE_ARGS(a); ThinArgs t{}; t.src = X; t.nw = a.in[I_L1N2]; t.mods = MODS1; t.sh_off = 3072; t.hdst = (bf16_t*)(a.ws + WS_R1 + 64 * MiB); t.rw = a.in[I_L1RW]; t.rb = a.in[I_L1RB]; t.layer = 2; t.dbg_off = (size_t)(WS_R1 - WS_TOK);
        thin_pass<false, 0, true, false, false>(c, a, t); __syncthreads(); }
#endif
    ROUTER_PHASE(13, 1, I_L1N2, I_L1RW, I_L1RB, MODS1)
    SEAM(13);
    MOE1_PHASE(14, 1, I_L1B1)
#if (REP_MASK >> 14) & 1
    __syncthreads();
    MOE1_PHASE(14, 1, I_L1B1)
#endif
    SEAM(14);
    MOE2_PHASE(15, 1, I_L1B2)
#if (REP_MASK >> 15) & 1
    __syncthreads();
    MOE2_PHASE(15, 1, I_L1B2)
#endif
    SEAM(15);
#ifdef PROBE_T16
    PH(16) { PHASE_ARGS(a); ThinArgs t{}; t.src = X; t.xdst = (float*)(a.ws + WS_R1); t.nw = a.in[I_FN]; t.cmods = MODS1; t.fdst = (float*)(a.ws + WS_R1 + 128 * MiB); t.layer = 1; t.Y = a.ws + WS_Y;
        thin_pass<true, 0, false, true, false>(c, a, t); __syncthreads(); }
#endif
    PH(16) {
        PHASE_ARGS(a); ThinArgs t{}; t.src = (const float*)X16; t.nw = a.in[I_FN]; t.cmods = MODS1; t.fdst = a.out; t.layer = 1; t.Y = a.ws + WS_Y;
        thin_pass<true, 0, false, true, false, true, false>(c, a, t);
    }
#undef IN
#undef SEAM
}

extern "C" void kernel_launch(void* const* d_in, const int* in_sizes, int n_in, void* d_out, int out_size, void* d_ws, size_t ws_size, hipStream_t stream) {
    static int grid = 0;
    if (grid == 0) {
        if (n_in != 31 || out_size != NTOK * DM || ws_size < WS_END) { fprintf(stderr, "kernel_launch: unexpected shapes (n_in %d, out %d, ws %zu)\n", n_in, out_size, ws_size); grid = -1; return; }
        int dev = 0, cus = 0, per_cu = 0;
        if (hipGetDevice(&dev) != hipSuccess || hipDeviceGetAttribute(&cus, hipDeviceAttributeMultiprocessorCount, dev) != hipSuccess) { grid = -1; return; }
        if (hipFuncSetAttribute((const void*)mk_fwd, hipFuncAttributeMaxDynamicSharedMemorySize, LDS_BYTES) != hipSuccess) { fprintf(stderr, "kernel_launch: hipFuncSetAttribute failed\n"); grid = -1; return; }
        if (hipOccupancyMaxActiveBlocksPerMultiprocessor(&per_cu, (const void*)mk_fwd, 512, LDS_BYTES) != hipSuccess || per_cu < 1) { fprintf(stderr, "kernel_launch: occupancy query says %d\n", per_cu); }
        (void)hipGetLastError();
        grid = cus;
    }
    if (grid < 0) return;
    if (hipMemsetAsync((char*)d_ws + WS_CTL, 0, CTL_ZERO_BYTES, stream) != hipSuccess) return;
    Args a{};
    for (int i = 0; i < 31; ++i) a.in[i] = (const float*)d_in[i];
    a.out = (float*)d_out; a.ws = (unsigned char*)d_ws;
#if ONE_LAUNCH
    a.ph_lo = 0; a.ph_hi = NPHASE;
    hipLaunchKernelGGL(mk_fwd, dim3(grid), dim3(512), LDS_BYTES, stream, a);
#else
    for (int p = 0; p < NPHASE; ++p) { a.ph_lo = p; a.ph_hi = p + 1; hipLaunchKernelGGL(mk_fwd, dim3(grid), dim3(512), LDS_BYTES, stream, a); }
#endif
}
```

```cpp
#define ONE_LAUNCH 1
#define CONV_IN_P11 1
#define CONV_IN_P3 1
#include <hip/hip_runtime.h>
#include <hip/hip_bf16.h>
#include <cmath>
#include <cstdint>
#include <cstdio>

#define LAS __attribute__((address_space(3)))
#define GAS __attribute__((address_space(1)))
typedef unsigned short bf16_t;
typedef short bf16x8 __attribute__((ext_vector_type(8)));
typedef short s16x4 __attribute__((ext_vector_type(4)));
typedef float f32x4 __attribute__((ext_vector_type(4)));
typedef float f32x2 __attribute__((ext_vector_type(2)));
typedef float f32x16 __attribute__((ext_vector_type(16)));
typedef unsigned u32x4 __attribute__((ext_vector_type(4)));
typedef unsigned u32x2 __attribute__((ext_vector_type(2)));

constexpr int NTOK = 32768, DM = 1024, SEQ = 8192, NB = 4;
constexpr int NEXP = 32, TOPK = 4, DEXP = 1024;
constexpr int EVEN_IN = 3848, ODD_IN = 1864;
constexpr int QKV0_LD = 3840, MER_LD = 768;
constexpr int L1N = 5120;
constexpr int ACT_ROWS = NTOK * TOPK + NEXP * 256;
constexpr float EPS = 1e-6f;
constexpr float LOG2E = 1.4426950408889634f;
constexpr float C2 = 0.125f * LOG2E;

constexpr size_t MiB = 1u << 20;
constexpr size_t WS_CTL = 0, CTL_ZERO_BYTES = 1 * MiB;
constexpr size_t WS_MODS = 1 * MiB;
constexpr size_t WS_BT0 = 2 * MiB;
constexpr size_t WS_WO0 = 10 * MiB;
constexpr size_t WS_BT1 = 12 * MiB;
constexpr size_t WS_WC1 = 22 * MiB;
constexpr size_t WS_W1T = 32 * MiB;
constexpr size_t WS_W2T = 160 * MiB;
constexpr size_t WS_H = 224 * MiB;
constexpr size_t WS_LF = 288 * MiB;
constexpr size_t WS_KB2 = 289 * MiB;
constexpr size_t WS_TOK = 290 * MiB;
constexpr size_t WS_SLOT = 294 * MiB;
constexpr size_t WS_GATE = 294 * MiB + 512 * 1024;
constexpr size_t WS_WI = 296 * MiB;
constexpr size_t WS_R1 = 300 * MiB;
constexpr size_t WS_QKV0 = WS_R1, WS_MER = WS_R1 + 240 * MiB;
constexpr size_t WS_ACT = WS_R1, WS_Y = WS_R1 + 272 * MiB;
constexpr size_t WS_QP = WS_R1, WS_CKV = WS_R1 + 256 * MiB, WS_QI = WS_R1 + 272 * MiB, WS_KI = WS_R1 + 304 * MiB, WS_SEL = WS_R1 + 308 * MiB, WS_CKVN = WS_R1 + 324 * MiB, WS_U = WS_R1 + 340 * MiB;
constexpr size_t WS_H8 = WS_R1 + 596 * MiB;
constexpr size_t WS_X16 = WS_H8 + 32 * MiB;
constexpr size_t WS_END = WS_X16 + 64 * MiB;
constexpr int CW_TMO = 0;
constexpr int CW_BAR = 4096;
constexpr int CW_CNT = 16384;

constexpr int RING_BYTES = 131072;
constexpr int MISC_OFF = 160 * 1024 - 256;
constexpr int LDS_BYTES = 160 * 1024;

#define LDS_WAIT() asm volatile("s_waitcnt lgkmcnt(0)" ::: "memory")
#define VM_WAIT() asm volatile("s_waitcnt vmcnt(0)" ::: "memory")

__device__ __forceinline__ unsigned f2bf(float f) { unsigned u = __builtin_bit_cast(unsigned, f); return (u + 0x7fffu + ((u >> 16) & 1u)) >> 16; }
__device__ __forceinline__ unsigned pk2(float lo, float hi) { return f2bf(lo) | (f2bf(hi) << 16); }
__device__ __forceinline__ float bf2f(unsigned short b) { return __builtin_bit_cast(float, (unsigned)b << 16); }
__device__ __forceinline__ unsigned cvt_pk_bf16(float lo, float hi) { unsigned r; asm volatile("v_cvt_pk_bf16_f32 %0, %1, %2" : "=v"(r) : "v"(lo), "v"(hi)); return r; }
__device__ __forceinline__ float wave_sum(float v) {
#pragma unroll
    for (int o = 1; o < 64; o <<= 1) v += __shfl_xor(v, o);
    return v;
}

#define XB_TMO      128
#define XB_XCNT(j)  (256  + 64 * (j))
#define XB_XSUB(j)  (1280 + 64 * (j))
#define XB_XGEN(j)  (2304 + 64 * (j))
#define XB_TOP      3328
#define XB_TOPGEN   3392
#define XCD_BAR_WORDS 3456
#define XB_SPIN_CAP (1u << 18)

__device__ __forceinline__ unsigned xb_ld(unsigned* p)              { return __hip_atomic_load(p, __ATOMIC_RELAXED, __HIP_MEMORY_SCOPE_AGENT); }
__device__ __forceinline__ unsigned xb_add(unsigned* p, unsigned v) { return __hip_atomic_fetch_add(p, v, __ATOMIC_RELAXED, __HIP_MEMORY_SCOPE_AGENT); }
__device__ __forceinline__ unsigned xb_xcc_id() { return (unsigned)__builtin_amdgcn_s_getreg((3 << 11) | 20) & 0xFu; }
#define XB_SPIN(cond, bar) do { unsigned _sp = 0; while (cond) { __builtin_amdgcn_s_sleep(1); \
    if ((++_sp & 255u) == 0u) { if (xb_ld(&(bar)[XB_TMO])) break; if (_sp > XB_SPIN_CAP) { atomicAdd(&(bar)[XB_TMO], 1u); break; } } } } while (0)

struct XcdBarrier { unsigned* bar; unsigned x; volatile LAS unsigned* st; };

__device__ __forceinline__ XcdBarrier xcd_barrier_post(unsigned* bar, volatile LAS unsigned* st, const bool thread0) {
    XcdBarrier b; b.bar = bar; b.x = xb_xcc_id(); b.st = st;
    if (thread0) (void)xb_add(&bar[XB_XCNT(b.x)], 1u);
    return b;
}
__device__ __forceinline__ void xcd_barrier_complete(unsigned* bar, unsigned x, unsigned& nloc, unsigned& nx) {
    const unsigned G = gridDim.x * gridDim.y * gridDim.z;
    unsigned sum, cnt, mine, sp = 0u;
    for (;;) {
        sum = 0u; cnt = 0u; mine = 0u;
#pragma unroll
        for (unsigned j = 0; j < 16; ++j) { const unsigned c = xb_ld(&bar[XB_XCNT(j)]); sum += c; cnt += (c > 0u) ? 1u : 0u; mine = (j == x) ? c : mine; }
        if (sum == G) break;
        __builtin_amdgcn_s_sleep(1);
        if ((++sp & 255u) == 0u) { if (xb_ld(&bar[XB_TMO])) break; if (sp > XB_SPIN_CAP) { atomicAdd(&bar[XB_TMO], 1u); break; } }
    }
    nloc = mine > 0u ? mine : 1u; nx = cnt > 0u ? cnt : 1u;
}
__device__ __forceinline__ void xcd_barrier(const XcdBarrier& b, const bool thread0) {
    asm volatile("s_waitcnt vmcnt(0)" ::: "memory");
    __syncthreads();
    if (thread0) {
        unsigned* bar = b.bar;
        __builtin_amdgcn_s_waitcnt(0);
        unsigned nloc = b.st[0], nx = b.st[1];
        if (nloc == 0u) { xcd_barrier_complete(bar, b.x, nloc, nx); b.st[0] = nloc; b.st[1] = nx; }
        const unsigned old = xb_add(&bar[XB_XSUB(b.x)], 1u);
        const unsigned gen = old / nloc;
        if (old + 1u == (gen + 1u) * nloc) {
            __builtin_amdgcn_fence(__ATOMIC_RELEASE, "agent");
            asm volatile("s_waitcnt vmcnt(0)" ::: "memory");
            const unsigned og = xb_add(&bar[XB_TOP], 1u);
            const unsigned tg = og / nx;
            if (og + 1u == (tg + 1u) * nx) xb_add(&bar[XB_TOPGEN], 1u);
            else XB_SPIN(xb_ld(&bar[XB_TOPGEN]) == tg, bar);
            __builtin_amdgcn_fence(__ATOMIC_ACQUIRE, "agent");
            xb_add(&bar[XB_XGEN(b.x)], 1u);
            asm volatile("s_waitcnt vmcnt(0)" ::: "memory");
        } else {
            XB_SPIN(xb_ld(&bar[XB_XGEN(b.x)]) == gen, bar);
            __builtin_amdgcn_fence(__ATOMIC_ACQUIRE, "agent");
            asm volatile("s_waitcnt vmcnt(0)" ::: "memory");
        }
    }
    __syncthreads();
}

#ifndef PG8_PEEL
#define PG8_PEEL 0
#endif
namespace pg8 {
constexpr int BM = 256, BK = 64, HALF = 128, HTB = HALF * BK * 2, STAGE_BYTES = 8 * HTB;
__host__ __device__ __forceinline__ int lds_byte(int r, int c) { const int st = (r >> 4) * 2 + (c >> 5), rr = r & 15, cc = c & 31, ob = rr * 64 + cc * 2; return st * 1024 + (ob ^ (((ob >> 9) & 1) << 5)); }
__host__ __device__ __forceinline__ void stage_rc(int b, int& R, int& C) { const int st = b / 1024, sb = b % 1024, swz = sb ^ (((sb >> 9) & 1) << 5); R = (st >> 1) * 16 + swz / 64; C = (st & 1) * 32 + (swz % 64) / 2; }
__host__ __device__ __forceinline__ int perm32(int rho) { const int n = rho >> 4, i = rho & 15; return 8 * (i >> 2) + 4 * n + (i & 3); }

struct Unit { int pm, pn, e, aux; };
typedef int i32x8 __attribute__((ext_vector_type(8)));
typedef int i32x4 __attribute__((ext_vector_type(4)));
__device__ __forceinline__ i32x8 cat8(bf16x8 lo, bf16x8 hi) { const i32x4 a = __builtin_bit_cast(i32x4, lo), b = __builtin_bit_cast(i32x4, hi); return __builtin_shufflevector(a, b, 0, 1, 2, 3, 4, 5, 6, 7); }
__device__ __forceinline__ void mfma_f8(f32x4& acc, const i32x8 a, const i32x8 b, const int sc) { asm volatile("v_mfma_scale_f32_16x16x128_f8f6f4 %0, %1, %2, %0, %3, %3 op_sel_hi:[0,0,0]" : "+v"(acc) : "v"(a), "v"(b), "v"(sc)); }
template <class Epi, class Sched, bool ALIGN_EPI, bool FP8 = false>
__device__ __forceinline__ void gemm_phase(LAS unsigned char* lds, const int tid, const bf16_t* Abase, int lda, int K, const Sched& S, const Epi& E) {
    const int wid = __builtin_amdgcn_readfirstlane(tid >> 6), lane = tid & 63, wr = wid >> 2, wc = wid & 3, fr = lane & 15, fq = lane >> 4;
    constexpr int ESZ = FP8 ? 1 : 2;
    const int nt = K * ESZ / 128;
    int R0, C0;
    if (FP8) { const int b_ = tid * 16; R0 = b_ >> 7; C0 = 8 * (((b_ >> 4) & 7) ^ ((R0 >> 1) & 7)); } else stage_rc(tid * 16, R0, C0);
    const int R1 = R0 + 64;
    const int Rb0 = Epi::PERM ? ((R0 & ~31) + perm32(R0 & 31)) : R0;
    unsigned voffB[2]; voffB[0] = (unsigned)(Rb0 * K * ESZ + C0 * 2); voffB[1] = voffB[0] + (unsigned)(64 * K * ESZ);
    const unsigned cA0 = (unsigned)C0 * 2u, cA1 = cA0, lda2 = (unsigned)(lda * ESZ);
    const size_t kstep = (size_t)(BK * 2);
    const unsigned ldsw = (unsigned)wid * 1024u;
    const int sw8 = (fr >> 1) & 7;
    const int aoff = FP8 ? (wr * 64 + fr) * 128 + (((2 * fq) ^ sw8) * 16) : lds_byte(wr * 64 + fr, fq * 8), boff = FP8 ? (wc * 32 + fr) * 128 + (((2 * fq) ^ sw8) * 16) : lds_byte(wc * 32 + fr, fq * 8);
#define PG8_SA(b, h) (((b) * 2 + (h)) * HTB)
#define PG8_SB(b, h) ((4 + (b) * 2 + (h)) * HTB)
#define PG8_STAGE(bufoff, gbase, voff) do { _Pragma("unroll") for (int _i = 0; _i < 2; ++_i) \
        __builtin_amdgcn_global_load_lds((const unsigned*)((const char*)(gbase) + (voff)[_i]), (LAS unsigned*)(lds + (bufoff) + ldsw + _i * 8192), 16, 0, 0); } while (0)
#define PG8_LDA(dst, b, h) do { _Pragma("unroll") for (int m = 0; m < 4; ++m) _Pragma("unroll") for (int k = 0; k < 2; ++k) dst[m][k] = *(const LAS bf16x8*)(lds + PG8_SA(b, h) + (k ? (FP8 ? (aoff ^ 16) : aoff + 1024) : aoff) + m * 2048); } while (0)
#define PG8_LDB(dst, b, h) do { _Pragma("unroll") for (int n = 0; n < 2; ++n) _Pragma("unroll") for (int k = 0; k < 2; ++k) dst[n][k] = *(const LAS bf16x8*)(lds + PG8_SB(b, h) + (k ? (FP8 ? (boff ^ 16) : boff + 1024) : boff) + n * 2048); } while (0)
#define PG8_MMA(ai, bj, At, Bt) do { __builtin_amdgcn_s_setprio(1); _Pragma("unroll") for (int m = 0; m < 4; ++m) _Pragma("unroll") for (int n = 0; n < 2; ++n) { \
        if (FP8) mfma_f8(acc[ai][bj][m][n], cat8(Bt[n][0], Bt[n][1]), cat8(At[m][0], At[m][1]), 0x7f7f7f7f); \
        else { _Pragma("unroll") for (int k = 0; k < 2; ++k) acc[ai][bj][m][n] = __builtin_amdgcn_mfma_f32_16x16x32_bf16(Bt[n][k], At[m][k], acc[ai][bj][m][n], 0, 0, 0); } } __builtin_amdgcn_s_setprio(0); } while (0)
#define PG8_WAIT_V(n) asm volatile("s_waitcnt vmcnt(" #n ")" ::: "memory")
#define PG8_WAIT_L(n) asm volatile("s_waitcnt lgkmcnt(" #n ")" ::: "memory")
#define PG8_BAR __builtin_amdgcn_s_barrier()
#define PG8_SCHED __builtin_amdgcn_sched_barrier(0)
#define PG8_SCHED8 do { if constexpr (FP8) __builtin_amdgcn_sched_barrier(0); } while (0)
#define PG8_OFFS(u, o0, o1) do { o0[0] = (unsigned)S.rowA(u, R0) * lda2 + cA0; o0[1] = (unsigned)S.rowA(u, R1) * lda2 + cA1; \
        o1[0] = (unsigned)S.rowA(u, HALF + R0) * lda2 + cA0; o1[1] = (unsigned)S.rowA(u, HALF + R1) * lda2 + cA1; } while (0)
    Unit cur, nxt; int ui = 0;
    if (!S.next(0, cur)) return;
    LAS float* const BL = (LAS float*)(lds + 131072 + 2048);
    LAS int* const NXT = (LAS int*)(lds + 131072 + 4096);
    f32x4 acc[2][2][4][2];
#pragma unroll
    for (int a = 0; a < 2; ++a)
#pragma unroll
        for (int b = 0; b < 2; ++b)
#pragma unroll
            for (int m = 0; m < 4; ++m)
#pragma unroll
                for (int n = 0; n < 2; ++n) acc[a][b][m][n] = (f32x4){0.f, 0.f, 0.f, 0.f};
    bf16x8 At[4][2], B0[2][2], B1[2][2];
    unsigned oc0[2], oc1[2], on0[2], on1[2];
    PG8_OFFS(cur, oc0, oc1);
    const char* const Ab = (const char*)Abase;
    const char* cB0 = S.bptr(cur, 0); const char* cB1 = S.bptr(cur, 1);
    PG8_STAGE(PG8_SB(0, 0), cB0, voffB); PG8_STAGE(PG8_SB(0, 1), cB1, voffB); PG8_STAGE(PG8_SA(0, 0), Ab, oc0); PG8_STAGE(PG8_SA(0, 1), Ab, oc1);
    if (wr == 1) PG8_BAR;
    PG8_WAIT_V(2); PG8_BAR;
    PG8_STAGE(PG8_SB(1, 0), cB0 + kstep, voffB); PG8_STAGE(PG8_SA(1, 0), Ab + kstep, oc0); PG8_STAGE(PG8_SB(1, 1), cB1 + kstep, voffB);
    PG8_WAIT_V(6); PG8_BAR;
    for (;;) {
        const bool has_next = S.next(ui + 1, nxt);
        const char* nB0 = cB0; const char* nB1 = cB1;
        on0[0] = oc0[0]; on0[1] = oc0[1]; on1[0] = oc1[0]; on1[1] = oc1[1];
        if (has_next) { nB0 = S.bptr(nxt, 0); nB1 = S.bptr(nxt, 1);
            if constexpr (Sched::ROWS_LDS) { int t_ = tid; asm volatile("" : "+v"(t_));
                if (wid < 4) __builtin_amdgcn_global_load_lds((const unsigned*)S.row_ptr(nxt, t_), (LAS unsigned*)(NXT + ((ui + 1) & 1) * 256 + wid * 64), 4, 0, 0); }
            else PG8_OFFS(nxt, on0, on1); }
        if constexpr (Epi::NBIAS > 0) { int t_ = tid; asm volatile("" : "+v"(t_)); if (wid < 4) __builtin_amdgcn_global_load_lds((const unsigned*)E.bias_ptr(cur, t_), (LAS unsigned*)(BL + (ui & 1) * 256 + wid * 64), 4, 0, 0); }
#define PG8_KBODY(A1, A2, B20, B21, O20, O21) do { \
            const char* a3_ = (A2) + kstep; const char* b30_ = (B20) + kstep; const char* b31_ = (B21) + kstep; \
            PG8_LDB(B0, 0, 0); PG8_LDB(B1, 0, 1); PG8_SCHED; PG8_LDA(At, 0, 0); PG8_STAGE(PG8_SA(1, 1), A1, oc1); \
            PG8_WAIT_V(8); PG8_WAIT_L(0); PG8_BAR; PG8_SCHED8; PG8_MMA(0, 0, At, B0); PG8_MMA(0, 1, At, B1); PG8_SCHED8; PG8_BAR; PG8_SCHED; \
            PG8_LDA(At, 0, 1); PG8_STAGE(PG8_SB(0, 0), B20, voffB); PG8_STAGE(PG8_SB(0, 1), B21, voffB); PG8_STAGE(PG8_SA(0, 0), A2, O20); \
            PG8_WAIT_V(8); PG8_WAIT_L(0); PG8_BAR; PG8_SCHED8; PG8_MMA(1, 0, At, B0); PG8_MMA(1, 1, At, B1); PG8_SCHED8; PG8_BAR; PG8_SCHED; \
            PG8_LDB(B0, 1, 0); PG8_LDB(B1, 1, 1); PG8_SCHED; PG8_LDA(At, 1, 0); PG8_STAGE(PG8_SA(0, 1), A2, O21); \
            PG8_WAIT_V(8); PG8_WAIT_L(0); PG8_BAR; PG8_SCHED8; PG8_MMA(0, 0, At, B0); PG8_MMA(0, 1, At, B1); PG8_SCHED8; PG8_BAR; PG8_SCHED; \
            PG8_LDA(At, 1, 1); PG8_STAGE(PG8_SB(1, 0), b30_, voffB); PG8_STAGE(PG8_SB(1, 1), b31_, voffB); PG8_STAGE(PG8_SA(1, 0), a3_, O20); \
            PG8_WAIT_V(8); PG8_WAIT_L(0); PG8_BAR; PG8_SCHED8; PG8_MMA(1, 0, At, B0); PG8_MMA(1, 1, At, B1); PG8_SCHED8; PG8_BAR; PG8_SCHED; } while (0)
#if PG8_PEEL
        for (int t = 0; t < nt - 2; t += 2) {
            const char* a1 = Ab + (size_t)(t + 1) * kstep; const char* a2 = Ab + (size_t)(t + 2) * kstep;
            const char* b20 = cB0 + (size_t)(t + 2) * kstep; const char* b21 = cB1 + (size_t)(t + 2) * kstep;
            PG8_KBODY(a1, a2, b20, b21, oc0, oc1);
        }
        { const char* a1 = Ab + (size_t)(nt - 1) * kstep; PG8_KBODY(a1, Ab, nB0, nB1, on0, on1); }
#else
        unsigned o20[2], o21[2];
#pragma unroll 1
        for (int t = 0; t < nt; t += 2) {
            const bool last = (t == nt - 2);
            const char* a1 = Ab + (size_t)(t + 1) * kstep; const char* a2 = last ? Ab : Ab + (size_t)(t + 2) * kstep;
            const char* b20 = last ? nB0 : cB0 + (size_t)(t + 2) * kstep; const char* b21 = last ? nB1 : cB1 + (size_t)(t + 2) * kstep;
            o20[0] = oc0[0]; o20[1] = oc0[1]; o21[0] = oc1[0]; o21[1] = oc1[1];
            if constexpr (Sched::ROWS_LDS) { if (last && has_next) { const LAS int* nx = NXT + ((ui + 1) & 1) * 256;
                o20[0] = (unsigned)nx[R0] * lda2 + cA0; o20[1] = (unsigned)nx[R1] * lda2 + cA1; o21[0] = (unsigned)nx[HALF + R0] * lda2 + cA0; o21[1] = (unsigned)nx[HALF + R1] * lda2 + cA1; } }
            else { if (last) { o20[0] = on0[0]; o20[1] = on0[1]; o21[0] = on1[0]; o21[1] = on1[1]; } }
            PG8_KBODY(a1, a2, b20, b21, o20, o21);
        }
#endif
#undef PG8_KBODY
        if constexpr (ALIGN_EPI) { if (wr == 0) PG8_BAR; }
        { int fr_ = fr, fq_ = fq; asm volatile("" : "+v"(fr_), "+v"(fq_));
          E(acc, cur, wr, wc, fr_, fq_, BL + (ui & 1) * 256); }
        if (!has_next) break;
#pragma unroll
        for (int a = 0; a < 2; ++a)
#pragma unroll
            for (int b = 0; b < 2; ++b)
#pragma unroll
                for (int m = 0; m < 4; ++m)
#pragma unroll
                    for (int n = 0; n < 2; ++n) acc[a][b][m][n] = (f32x4){0.f, 0.f, 0.f, 0.f};
        cur = nxt; cB0 = nB0; cB1 = nB1; oc0[0] = o20[0]; oc0[1] = o20[1]; oc1[0] = o21[0]; oc1[1] = o21[1]; ++ui;
        if constexpr (ALIGN_EPI) { if (wr == 1) PG8_BAR; }
    }
    PG8_WAIT_V(0);
    if constexpr (!ALIGN_EPI) { if (wr == 0) PG8_BAR; }
    PG8_BAR;
#undef PG8_SA
#undef PG8_SB
#undef PG8_STAGE
#undef PG8_LDA
#undef PG8_LDB
#undef PG8_MMA
#undef PG8_WAIT_V
#undef PG8_WAIT_L
#undef PG8_BAR
#undef PG8_SCHED
#undef PG8_SCHED8
#undef PG8_OFFS
}
}
struct Args { const float* in[31]; float* out; unsigned char* ws; int ph_lo, ph_hi; };
enum { I_X = 0, I_C, I_RELB, I_L0N1, I_L0ADAW, I_L0ADAB, I_L0WIN, I_L0FB, I_L0WOUT, I_L0N2, I_L0RW, I_L0RB, I_L0W1, I_L0B1, I_L0W2, I_L0B2,
       I_L1N1, I_L1ADAW, I_L1ADAB, I_L1WIN, I_L1KVN, I_L1WUKV, I_L1WOUT, I_L1N2, I_L1RW, I_L1RB, I_L1W1, I_L1B1, I_L1W2, I_L1B2, I_FN };

struct Ctx { LAS unsigned char* lds; int tid, lane, wave, G, vcu; };

__device__ __forceinline__ void transpose_item(const float* __restrict__ W, int ldw, int K, int nblk, bf16_t* WT, int row_off, float scale, LAS float* scr, int item, int lane) {
    const int kb = item / nblk, nb = item % nblk, k0 = 64 * kb, n0 = 32 * nb;
#pragma unroll 8
    for (int i = 0; i < 32; ++i) { const int kk = 2 * i + (lane >> 5); scr[kk * 33 + (lane & 31)] = W[(size_t)(k0 + kk) * ldw + n0 + (lane & 31)] * scale; }
    LDS_WAIT(); asm volatile("" ::: "memory");
    const int c = lane & 7;
#pragma unroll
    for (int j = 0; j < 4; ++j) { const int n = (lane >> 3) + 8 * j; const LAS float* s = scr + (8 * c) * 33 + n;
        u32x4 o; o.x = pk2(s[0 * 33], s[1 * 33]); o.y = pk2(s[2 * 33], s[3 * 33]); o.z = pk2(s[4 * 33], s[5 * 33]); o.w = pk2(s[6 * 33], s[7 * 33]);
        *(u32x4*)(WT + (size_t)(row_off + n0 + n) * K + k0 + 8 * c) = o; }
    LDS_WAIT(); asm volatile("" ::: "memory");
}
constexpr float FP8_SW = 64.f, FP8_SH = 8.f, FP8_SA = 4.f, FP8_SQP = 1024.f, FP8_SWC = 128.f, FP8_SU = 16.f, FP8_SY = 32.f, FP8_SQ = 64.f, FP8_SW0 = 256.f;
__device__ __forceinline__ unsigned char to_fp8(float a) { a = __builtin_amdgcn_fmed3f(a, -448.f, 448.f); return (unsigned char)(__builtin_amdgcn_cvt_pk_fp8_f32(a, 0.f, 0, false) & 0xff); }
__device__ __forceinline__ unsigned pk4_fp8(float a, float b, float c, float d) {
    a = __builtin_amdgcn_fmed3f(a, -448.f, 448.f); b = __builtin_amdgcn_fmed3f(b, -448.f, 448.f); c = __builtin_amdgcn_fmed3f(c, -448.f, 448.f); d = __builtin_amdgcn_fmed3f(d, -448.f, 448.f);
    int w = __builtin_amdgcn_cvt_pk_fp8_f32(a, b, 0, false); w = __builtin_amdgcn_cvt_pk_fp8_f32(c, d, w, true); return (unsigned)w; }
__device__ __forceinline__ void transpose_item_fp8(const float* __restrict__ W, int ldw, int K, int nblk, unsigned char* WT, int row_off, float scale, LAS float* scr, int item, int lane) {
    const int kb = item / nblk, nb = item % nblk, k0 = 64 * kb, n0 = 32 * nb;
#pragma unroll 8
    for (int i = 0; i < 32; ++i) { const int kk = 2 * i + (lane >> 5); scr[kk * 33 + (lane & 31)] = W[(size_t)(k0 + kk) * ldw + n0 + (lane & 31)] * scale; }
    LDS_WAIT(); asm volatile("" ::: "memory");
    const int n = lane & 31, kh = (lane >> 5) * 32; const LAS float* sp = scr + kh * 33 + n;
    u32x4 o0, o1;
    o0.x = pk4_fp8(sp[0 * 33], sp[1 * 33], sp[2 * 33], sp[3 * 33]); o0.y = pk4_fp8(sp[4 * 33], sp[5 * 33], sp[6 * 33], sp[7 * 33]); o0.z = pk4_fp8(sp[8 * 33], sp[9 * 33], sp[10 * 33], sp[11 * 33]); o0.w = pk4_fp8(sp[12 * 33], sp[13 * 33], sp[14 * 33], sp[15 * 33]);
    o1.x = pk4_fp8(sp[16 * 33], sp[17 * 33], sp[18 * 33], sp[19 * 33]); o1.y = pk4_fp8(sp[20 * 33], sp[21 * 33], sp[22 * 33], sp[23 * 33]); o1.z = pk4_fp8(sp[24 * 33], sp[25 * 33], sp[26 * 33], sp[27 * 33]); o1.w = pk4_fp8(sp[28 * 33], sp[29 * 33], sp[30 * 33], sp[31 * 33]);
    unsigned char* dst = WT + (size_t)(row_off + n0 + n) * K + k0 + kh;
    *(u32x4*)dst = o0; *(u32x4*)(dst + 16) = o1;
    LDS_WAIT(); asm volatile("" ::: "memory");
}
__device__ __forceinline__ void convert_moe_weights(const Ctx& c, const float* w1, const float* w2, unsigned char* W1T, unsigned char* W2T, LAS float* scr) {
    const int gw = c.vcu * 8 + c.wave, NGW = c.G * 8;
    constexpr int I1 = 16 * 64, I2 = 16 * 32;
    for (int it = gw; it < NEXP * (I1 + I2); it += NGW) {
        if (it < NEXP * I1) { const int e = it / I1, r = it % I1; transpose_item_fp8(w1 + (size_t)e * 1024 * 2048, 2048, 1024, 64, W1T + (size_t)e * 2048 * 1024, 0, FP8_SW, scr, r, c.lane); }
        else { const int q = it - NEXP * I1, e = q / I2, r = q % I2; transpose_item_fp8(w2 + (size_t)e * 1024 * 1024, 1024, 1024, 32, W2T + (size_t)e * 1024 * 1024, 0, FP8_SW, scr, r, c.lane); }
    }
}
__device__ __forceinline__ void convert_moe_item(int it, int lane, const float* w1, const float* w2, unsigned char* W1T, unsigned char* W2T, LAS float* scr) {
    constexpr int I1 = 16 * 64, I2 = 16 * 32;
    if (it < NEXP * I1) { const int e = it / I1, r = it % I1; transpose_item_fp8(w1 + (size_t)e * 1024 * 2048, 2048, 1024, 64, W1T + (size_t)e * 2048 * 1024, 0, FP8_SW, scr, r, lane); }
    else { const int q = it - NEXP * I1, e = q / I2, r = q % I2; transpose_item_fp8(w2 + (size_t)e * 1024 * 1024, 1024, 1024, 32, W2T + (size_t)e * 1024 * 1024, 0, FP8_SW, scr, r, lane); }
}
__device__ __forceinline__ void mods_items(const Ctx& c, const Args& a) {
    LAS float* sl = (LAS float*)(c.lds + 65536);
    LAS float* red = (LAS float*)(c.lds + 65536 + 16384);
    float* MODS = (float*)(a.ws + WS_MODS);
    bool have = false;
    for (int it = blockIdx.x; it < 192; it += c.G) {
        if (!have) { for (int i = c.tid; i < 4096; i += 512) { const float v = a.in[I_C][i]; sl[i] = v / (1.f + __expf(-v)); } have = true; __syncthreads(); }
        const int l = it / 96, cb = it % 96; const float* W = (l ? a.in[I_L1ADAW] : a.in[I_L0ADAW]) + cb * 64 + c.lane;
        float acc[4] = {0.f, 0.f, 0.f, 0.f};
        const int k0 = c.wave * 128;
#pragma unroll 16
        for (int k = 0; k < 128; ++k) { const float w = W[(size_t)(k0 + k) * 6144];
#pragma unroll
            for (int b = 0; b < 4; ++b) acc[b] += sl[b * 1024 + k0 + k] * w; }
#pragma unroll
        for (int b = 0; b < 4; ++b) red[(c.wave * 4 + b) * 64 + c.lane] = acc[b];
        __syncthreads();
        if (c.tid < 256) { const int b = c.tid >> 6, cc = c.tid & 63; float s = 0.f;
#pragma unroll
            for (int w = 0; w < 8; ++w) s += red[(w * 4 + b) * 64 + cc];
            MODS[(size_t)(l * 4 + b) * 6144 + cb * 64 + cc] = s + (l ? a.in[I_L1ADAB] : a.in[I_L0ADAB])[cb * 64 + cc]; }
        __syncthreads();
    }
}
__device__ __forceinline__ void absorb_items(const Ctx& c, const Args& a) {
    const int gw = c.vcu * 8 + c.wave, NGW = c.G * 8;
    const float* __restrict__ wukv = a.in[I_L1WUKV]; const float* __restrict__ win = a.in[I_L1WIN]; const float* __restrict__ wout = a.in[I_L1WOUT];
    unsigned char* BT1 = a.ws + WS_BT1; unsigned char* WC1 = a.ws + WS_WC1;
    for (int it = gw; it < 8192; it += NGW) {
        if (it < 4096) {
            const int h = it >> 8, cb = (it >> 4) & 15, kb = it & 15, k = kb * 64 + c.lane;
            f32x4 bk[16]; const f32x4* src = (const f32x4*)(win + (size_t)k * ODD_IN + h * 64);
#pragma unroll
            for (int i = 0; i < 16; ++i) bk[i] = src[i];
            for (int ci = 0; ci < 16; ++ci) { const int cc = cb * 16 + ci; const f32x4* wr = (const f32x4*)(wukv + (size_t)cc * 2048 + h * 64); float s = 0.f;
#pragma unroll
                for (int i = 0; i < 16; ++i) { const f32x4 w = wr[i]; s += bk[i].x * w.x + bk[i].y * w.y + bk[i].z * w.z + bk[i].w * w.w; }
                BT1[(size_t)(h * 256 + cc) * 1024 + k] = to_fp8(s * (C2 * FP8_SQP)); }
        } else {
            const int q = it - 4096, h = q >> 8, cb = (q >> 6) & 3, nb = q & 63, cc = cb * 64 + c.lane;
            f32x4 wv[16]; const f32x4* src = (const f32x4*)(wukv + (size_t)cc * 2048 + 1024 + h * 64);
#pragma unroll
            for (int i = 0; i < 16; ++i) wv[i] = src[i];
            float acc[16];
#pragma unroll
            for (int n = 0; n < 16; ++n) acc[n] = 0.f;
#pragma unroll
            for (int d = 0; d < 64; ++d) { const float w = wv[d >> 2][d & 3]; const f32x4* o = (const f32x4*)(wout + (size_t)(h * 64 + d) * 1024 + nb * 16);
#pragma unroll
                for (int n4 = 0; n4 < 4; ++n4) { const f32x4 ov = o[n4]; acc[n4 * 4 + 0] += w * ov.x; acc[n4 * 4 + 1] += w * ov.y; acc[n4 * 4 + 2] += w * ov.z; acc[n4 * 4 + 3] += w * ov.w; } }
#pragma unroll
            for (int n = 0; n < 16; ++n) WC1[(size_t)(nb * 16 + n) * 4096 + h * 256 + cc] = to_fp8(acc[n] * FP8_SWC);
        }
    }
}
__device__ __forceinline__ void p0_prologue(const Ctx& c, const Args& a) {
    mods_items(c, a);
    LAS float* scr = (LAS float*)(c.lds + c.wave * 8704);
    const int gw = c.vcu * 8 + c.wave, NGW = c.G * 8;
    unsigned char* BT0 = a.ws + WS_BT0; bf16_t* WO0 = (bf16_t*)(a.ws + WS_WO0); bf16_t* BT1 = (bf16_t*)(a.ws + WS_BT1);
    constexpr int IA = 16 * 48, IB = 16 * 72, IC = 12 * 32, ID = 16 * 26;
    for (int it = gw; it < IA + IB + IC + ID; it += NGW) {
        int r = it;
        if (r < IA) { transpose_item_fp8(a.in[I_L0WIN], EVEN_IN, 1024, 48, BT0, 0, ((r % 48) < 16 ? C2 : 1.f) * FP8_SW0, scr, r, c.lane); continue; } r -= IA;
        if (r < IB) { transpose_item_fp8(a.in[I_L0WIN] + 1544, EVEN_IN, 1024, 72, BT0, 1536, ((r % 72) < 24 ? C2 : 1.f) * FP8_SW0, scr, r, c.lane); continue; } r -= IB;
        if (r < IC) { transpose_item(a.in[I_L0WOUT], 1024, 768, 32, WO0, 0, 1.f, scr, r, c.lane); continue; } r -= IC;
        transpose_item(a.in[I_L1WIN] + 1024, ODD_IN, 1024, 26, BT1, 4096, 1.f, scr, r, c.lane);
    }
    absorb_items(c, a);
#ifndef CONV_IN_P3
    convert_moe_weights(c, a.in[I_L0W1], a.in[I_L0W2], a.ws + WS_W1T, a.ws + WS_W2T, scr);
#endif
}

__device__ __forceinline__ float reduce8(float (&v)[8], int lane) {
#pragma unroll
    for (int i = 0; i < 4; ++i) { const float send = (lane & 32) ? v[i] : v[i + 4], keep = (lane & 32) ? v[i + 4] : v[i]; v[i] = keep + __shfl_xor(send, 32); }
#pragma unroll
    for (int i = 0; i < 2; ++i) { const float send = (lane & 16) ? v[i] : v[i + 2], keep = (lane & 16) ? v[i + 2] : v[i]; v[i] = keep + __shfl_xor(send, 16); }
    { const float send = (lane & 8) ? v[0] : v[1], keep = (lane & 8) ? v[1] : v[0]; v[0] = keep + __shfl_xor(send, 8); }
    v[0] += __shfl_xor(v[0], 4); v[0] += __shfl_xor(v[0], 2); v[0] += __shfl_xor(v[0], 1);
    return v[0];
}
__device__ __forceinline__ float dot4(f32x4 a, f32x4 b) { return (a.x * b.x + a.y * b.y) + (a.z * b.z + a.w * b.w); }

struct ThinArgs {
    const float* src;
    float* xdst;
    const float* nw;
    const float* mods;
    int sh_off;
    const float* cmods;
    bf16_t* hdst;
    unsigned char* h8dst;
    float* fdst;
    const float* w8; int w8ld;
    const float* fb;
    float* e8dst;
    const float* rw; const float* rb;
    int layer;
    const unsigned char* Y;
    size_t dbg_off;
};
#ifndef TH_R
#define TH_R 4
#endif
constexpr int TH_RB = 131072;
template <bool COMBINE, int EXTRA, bool ROUTER, bool FINAL, bool COPYX, bool XIN16 = false, bool XOUT16 = false>
__device__ __forceinline__ void thin_pass(const Ctx& c, const Args& a, const ThinArgs& t) {
    const int lane = c.lane, wave = c.wave;
    unsigned* ctl = (unsigned*)(a.ws + WS_CTL);
    int* TOK = (int*)(a.ws + WS_TOK + (ROUTER ? t.dbg_off : 0)); unsigned* SLOT = (unsigned*)(a.ws + WS_SLOT + (ROUTER ? t.dbg_off : 0)); float* GATE = (float*)(a.ws + WS_GATE + (ROUTER ? t.dbg_off : 0));
    LAS float* W8 = (LAS float*)c.lds;
    LAS float* RW = (LAS float*)c.lds;
    LAS float* LG = (LAS float*)(c.lds + TH_RB) + wave * 128;
    LAS int* SELE = (LAS int*)(c.lds + TH_RB + 4096);
    LAS int* SELP = (LAS int*)(c.lds + TH_RB + 4096 + 2048);
    LAS int* LCNT = (LAS int*)(c.lds + TH_RB + 8192);
    LAS int* RBASE = (LAS int*)(c.lds + TH_RB + 8192 + 512);
    if (EXTRA) { for (int i = c.tid; i < 8192; i += 512) { const int col = i >> 10, k = i & 1023; W8[i] = t.w8[(size_t)k * t.w8ld + col]; } }
    if (ROUTER) { for (int i = c.tid; i < 8192; i += 512) { const int k = i >> 3, e4 = (i & 7) * 4; const f32x4 w = *(const f32x4*)(t.rw + (size_t)k * 32 + e4);
            RW[(e4 + 0) * 1024 + k] = w.x; RW[(e4 + 1) * 1024 + k] = w.y; RW[(e4 + 2) * 1024 + k] = w.z; RW[(e4 + 3) * 1024 + k] = w.w; } }
    if (COMBINE) { if (wave == 0) { int cn = (lane < 32) ? (int)ctl[CW_CNT + (t.layer * 32 + lane) * 16] : 0; int tl = (cn + 255) >> 8; int inc = tl;
#pragma unroll
            for (int o = 1; o < 32; o <<= 1) { const int v = __shfl_up(inc, o); if (lane >= o) inc += v; }
            if (lane < 32) RBASE[lane] = (inc - tl) * 256; } }
    __syncthreads();
#pragma unroll 1
    for (int rb = blockIdx.x; rb < NTOK / 128; rb += c.G) {
        const int row0 = rb * 128 + wave * 16, b = row0 / SEQ;
#define TH_LOAD_MODS() do { _Pragma("unroll") for (int j = 0; j < 4; ++j) { \
            const f32x4 nwv = *((const f32x4*)t.nw + lane + 64 * j); \
            if (FINAL) { Am[j] = nwv; Bm[j] = (f32x4){0.f, 0.f, 0.f, 0.f}; } \
            else { const f32x4 sc = *((const f32x4*)(t.mods + (size_t)b * 6144 + t.sh_off + 1024) + lane + 64 * j); Bm[j] = *((const f32x4*)(t.mods + (size_t)b * 6144 + t.sh_off) + lane + 64 * j); Am[j] = nwv * (sc + 1.0f); } \
            if (COMBINE) G2[j] = *((const f32x4*)(t.cmods + (size_t)b * 6144 + 5120) + lane + 64 * j); } } while (0)
        f32x4 Am[4], Bm[4], G2[4];
        if (!ROUTER) TH_LOAD_MODS();
        if (ROUTER) { if (c.tid < 32) LCNT[c.tid] = 0; __syncthreads(); }
        constexpr int R = ROUTER ? TH_R : 2;
#pragma unroll 1
        for (int rg = 0; rg < 16; rg += R) {
            if (ROUTER) { asm volatile("" ::: "memory"); TH_LOAD_MODS(); }
            f32x4 h[R][4];
            f32x4 vv[R][4]; unsigned yy[COMBINE ? R : 1][4][4]; float gg[COMBINE ? R : 1][4];
#pragma unroll
            for (int r = 0; r < R; ++r) { const int row = row0 + rg + r;
                if (XIN16) { const u32x2* xr = (const u32x2*)((const bf16_t*)t.src + (size_t)row * DM) + lane;
#pragma unroll
                    for (int j = 0; j < 4; ++j) { const u32x2 w = __builtin_nontemporal_load(xr + 64 * j); vv[r][j] = (f32x4){__builtin_bit_cast(float, w.x << 16), __builtin_bit_cast(float, w.x & 0xffff0000u), __builtin_bit_cast(float, w.y << 16), __builtin_bit_cast(float, w.y & 0xffff0000u)}; } }
                else { const f32x4* xr = (const f32x4*)(t.src + (size_t)row * DM) + lane;
#pragma unroll
                    for (int j = 0; j < 4; ++j) vv[r][j] = __builtin_nontemporal_load(xr + 64 * j); } }
            if (COMBINE) {
#pragma unroll
                for (int r = 0; r < R; ++r) { const int row = row0 + rg + r;
#pragma unroll
                    for (int k = 0; k < 4; ++k) { const unsigned info = SLOT[row * 4 + k]; gg[r][k] = GATE[row * 4 + k]; const int yrow = RBASE[info >> 24] + (int)(info & 0xffffffu);
                        const unsigned* yr = (const unsigned*)(t.Y + (size_t)yrow * DEXP) + lane;
#pragma unroll
                        for (int j = 0; j < 4; ++j) yy[r][k][j] = __builtin_nontemporal_load(yr + 64 * j); } }
            }
#pragma unroll
            for (int r = 0; r < R; ++r) {
                const int row = row0 + rg + r;
                f32x4 v[4];
#pragma unroll
                for (int j = 0; j < 4; ++j) v[j] = vv[r][j];
                if (COMBINE) {
#pragma unroll
                    for (int k = 0; k < 4; ++k) { const float g = gg[r][k] * (1.0f / FP8_SY);
#pragma unroll
                        for (int j = 0; j < 4; ++j) { const int y = (int)yy[r][k][j]; const f32x2 lo = __builtin_amdgcn_cvt_pk_f32_fp8(y, false), hi2 = __builtin_amdgcn_cvt_pk_f32_fp8(y, true); const f32x4 yf = {lo.x, lo.y, hi2.x, hi2.y};
                            v[j] += G2[j] * (yf * g); } }
                }
                if ((COMBINE || COPYX) && !FINAL) {
                    if (XOUT16) { u32x2* xo = (u32x2*)((bf16_t*)t.xdst + (size_t)row * DM) + lane;
#pragma unroll
                        for (int j = 0; j < 4; ++j) { u32x2 w; w.x = pk2(v[j].x, v[j].y); w.y = pk2(v[j].z, v[j].w); xo[64 * j] = w;
                            v[j] = (f32x4){__builtin_bit_cast(float, w.x << 16), __builtin_bit_cast(float, w.x & 0xffff0000u), __builtin_bit_cast(float, w.y << 16), __builtin_bit_cast(float, w.y & 0xffff0000u)}; } }
                    else { f32x4* xo = (f32x4*)(t.xdst + (size_t)row * DM) + lane;
#pragma unroll
                        for (int j = 0; j < 4; ++j) xo[64 * j] = v[j]; } }
                f32x2 ss2 = {0.f, 0.f};
#pragma unroll
                for (int j = 0; j < 4; ++j) { ss2 = __builtin_elementwise_fma((f32x2){v[j].x, v[j].y}, (f32x2){v[j].x, v[j].y}, ss2); ss2 = __builtin_elementwise_fma((f32x2){v[j].z, v[j].w}, (f32x2){v[j].z, v[j].w}, ss2); }
                const float ss = ss2.x + ss2.y;
                const float rs = 1.0f / sqrtf(wave_sum(ss) * (1.0f / DM) + EPS);
#pragma unroll
                for (int j = 0; j < 4; ++j) h[r][j] = (v[j] * rs) * Am[j] + Bm[j];
                if (FINAL) { f32x4* o = (f32x4*)(t.fdst + (size_t)row * DM) + lane;
#pragma unroll
                    for (int j = 0; j < 4; ++j) __builtin_nontemporal_store(h[r][j], o + 64 * j); }
                else if (ROUTER || EXTRA == 1) { unsigned* o = (unsigned*)((unsigned char*)t.hdst + (size_t)row * DM) + lane;
#pragma unroll
                    for (int j = 0; j < 4; ++j) o[64 * j] = pk4_fp8(h[r][j].x * FP8_SH, h[r][j].y * FP8_SH, h[r][j].z * FP8_SH, h[r][j].w * FP8_SH); }
                else { u32x2* o = (u32x2*)(t.hdst + (size_t)row * DM) + lane;
#pragma unroll
                    for (int j = 0; j < 4; ++j) { u32x2 w; w.x = pk2(h[r][j].x, h[r][j].y); w.y = pk2(h[r][j].z, h[r][j].w); o[64 * j] = w; }
                    if (EXTRA == 2) { unsigned* o8 = (unsigned*)(t.h8dst + (size_t)row * DM) + lane;
#pragma unroll
                        for (int j = 0; j < 4; ++j) o8[64 * j] = pk4_fp8(h[r][j].x * FP8_SH, h[r][j].y * FP8_SH, h[r][j].z * FP8_SH, h[r][j].w * FP8_SH); } }
                if (EXTRA) {
                    float acc[8];
#pragma unroll
                    for (int cc = 0; cc < 8; ++cc) { f32x2 s2 = {0.f, 0.f};
#pragma unroll
                        for (int j = 0; j < 4; ++j) { const f32x4 w = *((const LAS f32x4*)(W8 + cc * 1024) + lane + 64 * j); s2 = __builtin_elementwise_fma((f32x2){h[r][j].x, h[r][j].y}, (f32x2){w.x, w.y}, s2); s2 = __builtin_elementwise_fma((f32x2){h[r][j].z, h[r][j].w}, (f32x2){w.z, w.w}, s2); }
                        acc[cc] = s2.x + s2.y; if (cc & 1) __builtin_amdgcn_sched_barrier(0); }
                    const float tot = reduce8(acc, lane); const int col = lane >> 3;
                    if ((lane & 7) == 0) {
                        if (EXTRA == 1) { const float z = tot + t.fb[col]; const float lf = fminf(z, 0.f) - log1pf(__expf(-fabsf(z))); t.e8dst[(size_t)(b * 8 + col) * SEQ + (row - b * SEQ)] = lf; }
                        else t.e8dst[(size_t)row * 8 + col] = tot;
                    }
                }
            }
            if (ROUTER) {
#pragma unroll 1
                for (int ec = 0; ec < 4; ++ec) {
                    float acc[R][8]; f32x2 acc2[R][8];
#pragma unroll
                    for (int r = 0; r < R; ++r)
#pragma unroll
                        for (int e = 0; e < 8; ++e) acc2[r][e] = (f32x2){0.f, 0.f};
#pragma unroll
                    for (int e = 0; e < 8; ++e)
#pragma unroll
                        for (int j = 0; j < 4; ++j) { const f32x4 w = *((const LAS f32x4*)(RW + (ec * 8 + e) * 1024) + lane + 64 * j); const f32x2 wl = {w.x, w.y}, wh = {w.z, w.w};
#pragma unroll
                            for (int r = 0; r < R; ++r) { const f32x2 hl = {h[r][j].x, h[r][j].y}, hh = {h[r][j].z, h[r][j].w}; acc2[r][e] = __builtin_elementwise_fma(hl, wl, acc2[r][e]); acc2[r][e] = __builtin_elementwise_fma(hh, wh, acc2[r][e]); }
                            if (j == 3 && (e & 1)) __builtin_amdgcn_sched_barrier(0); }
#pragma unroll
                    for (int r = 0; r < R; ++r)
#pragma unroll
                        for (int e = 0; e < 8; ++e) acc[r][e] = acc2[r][e].x + acc2[r][e].y;
#pragma unroll
                    for (int r = 0; r < R; ++r) { const float tot = reduce8(acc[r], lane); if ((lane & 7) == 0) LG[r * 32 + ec * 8 + (lane >> 3)] = tot + t.rb[ec * 8 + (lane >> 3)]; }
                }
                LDS_WAIT(); asm volatile("" ::: "memory");
                {
                    const int r = lane >> 4, sub = lane & 15;
                    float v0 = LG[r * 32 + sub], v1 = LG[r * 32 + 16 + sub];
                    float tv[4]; int ti[4];
#pragma unroll
                    for (int k = 0; k < 4; ++k) {
                        const bool s1 = v1 > v0; float bv = s1 ? v1 : v0; int bi = s1 ? sub + 16 : sub;
#pragma unroll
                        for (int o = 1; o < 16; o <<= 1) { const float ov = __shfl_xor(bv, o); const int oi = __shfl_xor(bi, o); const bool take = (ov > bv) | ((ov == bv) & (oi < bi)); bv = take ? ov : bv; bi = take ? oi : bi; }
                        tv[k] = bv; ti[k] = bi; v0 = (bi == sub) ? -INFINITY : v0; v1 = (bi == sub + 16) ? -INFINITY : v1;
                    }
                    if (sub == 0 && r < R) {
                        const float e1 = __expf(tv[1] - tv[0]), e2 = __expf(tv[2] - tv[0]), e3 = __expf(tv[3] - tv[0]); const float inv = 1.0f / (1.0f + e1 + e2 + e3);
                        const float gk[4] = {inv, e1 * inv, e2 * inv, e3 * inv};
                        const int rl = wave * 16 + rg + r, row = row0 + rg + r;
#pragma unroll
                        for (int k = 0; k < 4; ++k) { const int p = __hip_atomic_fetch_add((LAS int*)&LCNT[ti[k]], 1, __ATOMIC_RELAXED, __HIP_MEMORY_SCOPE_WORKGROUP); SELE[rl * 4 + k] = ti[k]; SELP[rl * 4 + k] = p; GATE[row * 4 + k] = gk[k]; }
                    }
                }
                asm volatile("" ::: "memory");
            }
        }
        if (ROUTER) {
            __syncthreads();
            if (c.tid < 32) LCNT[32 + c.tid] = (int)__hip_atomic_fetch_add(ctl + CW_CNT + (t.layer * 32 + c.tid) * 16, (unsigned)LCNT[c.tid], __ATOMIC_RELAXED, __HIP_MEMORY_SCOPE_AGENT);
            __syncthreads();
            { const int rl = c.tid >> 2, k = c.tid & 3, e = SELE[rl * 4 + k], p = LCNT[32 + e] + SELP[rl * 4 + k], row = rb * 128 + rl;
              TOK[(size_t)e * NTOK + p] = row; SLOT[row * 4 + k] = ((unsigned)e << 24) | (unsigned)p; }
            __syncthreads();
        }
    }
}
struct DenseSched {
    static constexpr bool ROWS_LDS = false;
    const char* Bt; int K, nN, nU, G, vcu;
    __device__ __forceinline__ bool next(int i, pg8::Unit& u) const { const int L = i * G + vcu; if (L >= nU) return false; u.pm = L / nN; u.pn = L % nN; u.e = 0; u.aux = 256; return true; }
    __device__ __forceinline__ int rowA(const pg8::Unit& u, int r) const { return u.pm * 256 + r; }
    __device__ __forceinline__ const char* bptr(const pg8::Unit& u, int half) const { return Bt + (size_t)(u.pn * 256 + half * 128) * K * 2; }
};
constexpr int MOE_TS = 131072 + 1024;
__device__ __forceinline__ void moe_tables(const Ctx& c, const unsigned* ctl, int layer) {
    LAS int* TS = (LAS int*)(c.lds + MOE_TS); LAS int* CN = TS + 64;
    if (c.wave == 0) { const int cn = (c.lane < 32) ? (int)ctl[CW_CNT + (layer * 32 + c.lane) * 16] : 0; const int tl = (cn + 255) >> 8; int inc = tl;
#pragma unroll
        for (int o = 1; o < 32; o <<= 1) { const int v = __shfl_up(inc, o); if (c.lane >= o) inc += v; }
        if (c.lane < 32) { TS[c.lane + 1] = inc; CN[c.lane] = cn; } if (c.lane == 0) TS[0] = 0; }
    __syncthreads();
}
template <int NTN, bool GATHER>
struct MoeSched {
    static constexpr bool ROWS_LDS = GATHER;
    const LAS int* TS; const LAS int* CN; const int* TOK; const char* W; int G, vcu, total;
    __device__ __forceinline__ const int* row_ptr(const pg8::Unit& u, int r) const { return TOK + (size_t)u.e * NTOK + (u.aux >> 9) + min(r, u.aux & 511); }
    __device__ __forceinline__ bool next(int i, pg8::Unit& u) const {
        const int L = i * G + vcu;
        if (L >= total * NTN) return false;
        const int mt = L / NTN; int e = 0;
#pragma unroll
        for (int j = 1; j < 32; ++j) e += (mt >= TS[j]) ? 1 : 0;
        e = __builtin_amdgcn_readfirstlane(e);
        u.pm = mt; u.pn = L % NTN; u.e = e; const int r0 = (mt - __builtin_amdgcn_readfirstlane(TS[e])) * 256; u.aux = (r0 << 9) | (min(__builtin_amdgcn_readfirstlane(CN[e]) - r0, 256) - 1);
        return true;
    }
    __device__ __forceinline__ int rowA(const pg8::Unit& u, int r) const {
        if (GATHER) { const int p = (u.aux >> 9) + min(r, u.aux & 511); return TOK[(size_t)u.e * NTOK + p]; }
        return u.pm * 256 + r;
    }
    __device__ __forceinline__ const char* bptr(const pg8::Unit& u, int half) const {
        if (GATHER) return W + ((size_t)u.e * 2048 + half * 1024 + u.pn * 128) * 1024;
        return W + ((size_t)u.e * 1024 + u.pn * 256 + half * 128) * 1024;
    }
};
struct EpiBf16Plain {
    static constexpr bool PERM = true; static constexpr int NBIAS = 0; bf16_t* O; int ld; float sc;
    __device__ __forceinline__ void operator()(const f32x4 (&acc)[2][2][4][2], const pg8::Unit& u, int wr, int wc, int fr, int fq, const LAS float*) const {
#pragma unroll
        for (int ai = 0; ai < 2; ++ai)
#pragma unroll
            for (int m = 0; m < 4; ++m) { bf16_t* rowp = O + (size_t)(u.pm * 256 + ai * 128 + wr * 64 + m * 16 + fr) * ld + u.pn * 256 + wc * 32 + 8 * fq;
#pragma unroll
                for (int bj = 0; bj < 2; ++bj) { const f32x4 v0 = acc[ai][bj][m][0] * sc, v1 = acc[ai][bj][m][1] * sc; u32x4 w; w.x = cvt_pk_bf16(v0[0], v0[1]); w.y = cvt_pk_bf16(v0[2], v0[3]); w.z = cvt_pk_bf16(v1[0], v1[1]); w.w = cvt_pk_bf16(v1[2], v1[3]);
                    *(u32x4*)(rowp + bj * 128) = w; } }
    }
};
__device__ __forceinline__ unsigned pk_f16(float a, float b) { const _Float16 x = (_Float16)a, y = (_Float16)b; return (unsigned)__builtin_bit_cast(unsigned short, x) | ((unsigned)__builtin_bit_cast(unsigned short, y) << 16); }
struct EpiFp8Plain {
    static constexpr bool PERM = true; static constexpr int NBIAS = 0; unsigned char* O; int ld; float sc;
    __device__ __forceinline__ void operator()(const f32x4 (&acc)[2][2][4][2], const pg8::Unit& u, int wr, int wc, int fr, int fq, const LAS float*) const {
#pragma unroll
        for (int ai = 0; ai < 2; ++ai)
#pragma unroll
            for (int m = 0; m < 4; ++m) { unsigned char* rowp = O + (size_t)(u.pm * 256 + ai * 128 + wr * 64 + m * 16 + fr) * ld + u.pn * 256 + wc * 32 + 8 * fq;
#pragma unroll
                for (int bj = 0; bj < 2; ++bj) { const f32x4 v0 = acc[ai][bj][m][0] * sc, v1 = acc[ai][bj][m][1] * sc; u32x2 w; w.x = pk4_fp8(v0[0], v0[1], v0[2], v0[3]); w.y = pk4_fp8(v1[0], v1[1], v1[2], v1[3]);
                    *(u32x2*)(rowp + bj * 128) = w; } }
    }
};
struct EpiL1Proj {
    static constexpr bool PERM = true; static constexpr int NBIAS = 0; bf16_t* QP; bf16_t* CKV; bf16_t* QI; bf16_t* KI;
    __device__ __forceinline__ void operator()(const f32x4 (&acc)[2][2][4][2], const pg8::Unit& u, int wr, int wc, int fr, int fq, const LAS float*) const {
        bf16_t* base; int ld, c0; bool f16 = false; int lim = 256;
        if (u.pn == 0) { base = CKV; ld = 256; c0 = 0; } else if (u.pn < 3) { base = QI; ld = 512; c0 = (u.pn - 1) * 256; f16 = true; } else { base = KI; ld = 64; c0 = 0; f16 = true; lim = 64; }
#pragma unroll
        for (int ai = 0; ai < 2; ++ai)
#pragma unroll
            for (int m = 0; m < 4; ++m) { bf16_t* rowp = base + (size_t)(u.pm * 256 + ai * 128 + wr * 64 + m * 16 + fr) * ld + c0;
#pragma unroll
                for (int bj = 0; bj < 2; ++bj) { const int col = bj * 128 + wc * 32 + 8 * fq; const f32x4 v0 = acc[ai][bj][m][0], v1 = acc[ai][bj][m][1]; u32x4 w;
                    if (f16) { w.x = pk_f16(v0[0], v0[1]); w.y = pk_f16(v0[2], v0[3]); w.z = pk_f16(v1[0], v1[1]); w.w = pk_f16(v1[2], v1[3]); }
                    else { w.x = cvt_pk_bf16(v0[0], v0[1]); w.y = cvt_pk_bf16(v0[2], v0[3]); w.z = cvt_pk_bf16(v1[0], v1[1]); w.w = cvt_pk_bf16(v1[2], v1[3]); }
                    if (u.pn == 3) { if (col < 64) { const int row = u.pm * 256 + ai * 128 + wr * 64 + m * 16 + fr; *(u32x4*)(KI + (size_t)(row >> 6) * 4096 + (col >> 3) * 512 + (row & 63) * 8) = w; } }
                    else if (col < lim) *(u32x4*)(rowp + col) = w; } }
    }
};
template <bool XS16, bool XO16>
struct EpiResid {
    static constexpr bool PERM = false; static constexpr int NBIAS = 0; const void* Xs; void* X; const float* gate; float sc;
    __device__ __forceinline__ void operator()(const f32x4 (&acc)[2][2][4][2], const pg8::Unit& u, int wr, int wc, int fr, int fq, const LAS float*) const {
        const int b = (u.pm * 256) / SEQ; const int col0 = u.pn * 256 + wc * 32 + 4 * fq;
        f32x4 gv[2][2];
#pragma unroll
        for (int bj = 0; bj < 2; ++bj)
#pragma unroll
            for (int n = 0; n < 2; ++n) gv[bj][n] = *(const f32x4*)(gate + (size_t)b * 6144 + col0 + bj * 128 + n * 16) * sc;
#pragma unroll
        for (int ai = 0; ai < 2; ++ai)
#pragma unroll
            for (int m = 0; m < 4; ++m) { const size_t off = (size_t)(u.pm * 256 + ai * 128 + wr * 64 + m * 16 + fr) * DM + col0;
#pragma unroll
                for (int bj = 0; bj < 2; ++bj)
#pragma unroll
                    for (int n = 0; n < 2; ++n) { const size_t o_ = off + bj * 128 + n * 16; f32x4 xs;
                        if (XS16) { const u32x2 w = *(const u32x2*)((const bf16_t*)Xs + o_); xs = (f32x4){__builtin_bit_cast(float, w.x << 16), __builtin_bit_cast(float, w.x & 0xffff0000u), __builtin_bit_cast(float, w.y << 16), __builtin_bit_cast(float, w.y & 0xffff0000u)}; }
                        else xs = *(const f32x4*)((const float*)Xs + o_);
                        const f32x4 r_ = xs + gv[bj][n] * acc[ai][bj][m][n];
                        if (XO16) { u32x2 w; w.x = pk2(r_.x, r_.y); w.y = pk2(r_.z, r_.w); *(u32x2*)((bf16_t*)X + o_) = w; } else *(f32x4*)((float*)X + o_) = r_; }
                if (m & 1) asm volatile("" ::: "memory"); }
    }
};
struct EpiSwiglu {
    static constexpr bool PERM = true; static constexpr int NBIAS = 256; unsigned char* ACT; const float* b1;
    __device__ __forceinline__ const float* bias_ptr(const pg8::Unit& u, int i) const { return b1 + (size_t)u.e * 2048 + (i >> 7) * 1024 + u.pn * 128 + (i & 127); }
    __device__ __forceinline__ void operator()(const f32x4 (&acc)[2][2][4][2], const pg8::Unit& u, int wr, int wc, int fr, int fq, const LAS float* bl_) const {
        const int col = u.pn * 128 + wc * 32 + 8 * fq; const LAS float* bp = bl_ + wc * 32 + 8 * fq;
        const f32x4 bg0 = *(const LAS f32x4*)bp, bg1 = *(const LAS f32x4*)(bp + 4), bl0 = *(const LAS f32x4*)(bp + 128), bl1 = *(const LAS f32x4*)(bp + 132);
        constexpr float S1 = 1.0f / (FP8_SH * FP8_SW);
#pragma unroll
        for (int ai = 0; ai < 2; ++ai)
#pragma unroll
            for (int m = 0; m < 4; ++m) { f32x2 o2[4];
#pragma unroll
                for (int n = 0; n < 2; ++n)
#pragma unroll
                    for (int i2 = 0; i2 < 2; ++i2) { const f32x4 ag = acc[ai][0][m][n], al = acc[ai][1][m][n]; const f32x4 bgv = n ? bg1 : bg0, blv = n ? bl1 : bl0;
                        f32x2 g = (f32x2){ag[2 * i2], ag[2 * i2 + 1]} * S1 + (f32x2){bgv[2 * i2], bgv[2 * i2 + 1]};
                        f32x2 l = (f32x2){al[2 * i2], al[2 * i2 + 1]} * S1 + (f32x2){blv[2 * i2], blv[2 * i2 + 1]};
                        g.x = fminf(g.x, 7.0f); g.y = fminf(g.y, 7.0f); l.x = __builtin_amdgcn_fmed3f(l.x, -7.0f, 7.0f); l.y = __builtin_amdgcn_fmed3f(l.y, -7.0f, 7.0f);
                        f32x2 z = g * (-1.702f * LOG2E); z.x = __builtin_amdgcn_exp2f(z.x); z.y = __builtin_amdgcn_exp2f(z.y); z = z + 1.0f; z.x = __builtin_amdgcn_rcpf(z.x); z.y = __builtin_amdgcn_rcpf(z.y);
                        o2[n * 2 + i2] = (g * z) * (l * FP8_SA + FP8_SA); }
                u32x2 w; w.x = pk4_fp8(o2[0].x, o2[0].y, o2[1].x, o2[1].y); w.y = pk4_fp8(o2[2].x, o2[2].y, o2[3].x, o2[3].y);
                *(u32x2*)(ACT + (size_t)(u.pm * 256 + ai * 128 + wr * 64 + m * 16 + fr) * DEXP + col) = w; }
    }
};
struct EpiBiasBf16 {
    static constexpr bool PERM = true; static constexpr int NBIAS = 256; unsigned char* Y; const float* b2;
    __device__ __forceinline__ const float* bias_ptr(const pg8::Unit& u, int i) const { return b2 + (size_t)u.e * 1024 + u.pn * 256 + i; }
    __device__ __forceinline__ void operator()(const f32x4 (&acc)[2][2][4][2], const pg8::Unit& u, int wr, int wc, int fr, int fq, const LAS float* bl_) const {
        const int col0 = u.pn * 256 + wc * 32 + 8 * fq; const LAS float* bp = bl_ + wc * 32 + 8 * fq;
        f32x4 bv[2][2];
#pragma unroll
        for (int bj = 0; bj < 2; ++bj)
#pragma unroll
            for (int n = 0; n < 2; ++n) bv[bj][n] = *(const LAS f32x4*)(bp + bj * 128 + 4 * n);
#pragma unroll
        for (int ai = 0; ai < 2; ++ai)
#pragma unroll
            for (int m = 0; m < 4; ++m) { unsigned char* rowp = Y + (size_t)(u.pm * 256 + ai * 128 + wr * 64 + m * 16 + fr) * DEXP + col0;
#pragma unroll
                for (int bj = 0; bj < 2; ++bj) { const f32x4 v0 = (acc[ai][bj][m][0] * (1.0f / (FP8_SA * FP8_SW)) + bv[bj][0]) * FP8_SY, v1 = (acc[ai][bj][m][1] * (1.0f / (FP8_SA * FP8_SW)) + bv[bj][1]) * FP8_SY; u32x2 w; w.x = pk4_fp8(v0[0], v0[1], v0[2], v0[3]); w.y = pk4_fp8(v1[0], v1[1], v1[2], v1[3]);
                    *(u32x2*)(rowp + bj * 128) = w; } }
    }
};

struct EpiNone { static constexpr bool PERM = true; static constexpr int NBIAS = 0;
    __device__ __forceinline__ void operator()(const f32x4 (&acc)[2][2][4][2], const pg8::Unit& u, int wr, int wc, int fr, int fq, const LAS float*) const { asm volatile("" :: "v"(acc[0][0][0][0]), "v"(acc[1][1][3][1])); } };
namespace att {
__device__ __forceinline__ int crow(int r, int hi) { return (r & 3) + 8 * (r >> 2) + 4 * hi; }
__device__ __forceinline__ void glds16(const void* gsrc, unsigned lds_dst) { unsigned keep;
    asm volatile("s_mov_b32 %0, m0\n\ts_mov_b32 m0, %2\n\ts_nop 0\n\tglobal_load_lds_dwordx4 %1, off\n\ts_mov_b32 m0, %0" : "=&s"(keep) : "v"(gsrc), "s"(lds_dst) : "memory"); }
__device__ __forceinline__ unsigned cvtpk(float lo, float hi) { typedef __bf16 bf2 __attribute__((ext_vector_type(2))); f32x2 v = {lo, hi}; bf2 b = __builtin_convertvector(v, bf2); return __builtin_bit_cast(unsigned, b); }
__device__ __forceinline__ int kimg(int r, int g) { return r * 128 + ((g ^ ((r >> 1) & 7)) * 16); }
__device__ __forceinline__ void qkt(f32x16& p0, f32x16& p1, const LAS unsigned char* Kslot, const bf16x8* qr, int r32, int hi) {
    p0 = f32x16{}; p1 = f32x16{};
#pragma unroll
    for (int d0 = 0; d0 < 4; ++d0) {
        const bf16x8 b0 = *(const LAS bf16x8*)(Kslot + kimg(r32, 2 * d0 + hi)), b1 = *(const LAS bf16x8*)(Kslot + 4096 + kimg(r32, 2 * d0 + hi));
        p0 = __builtin_amdgcn_mfma_f32_32x32x16_bf16(b0, qr[d0], p0, 0, 0, 0); p1 = __builtin_amdgcn_mfma_f32_32x32x16_bf16(b1, qr[d0], p1, 0, 0, 0); }
}
__device__ __forceinline__ void pv(f32x16* o, int vb, bf16x8 pa0, bf16x8 pa1, bf16x8 pa2, bf16x8 pa3) {
    s16x4 lo[2][4], hi[2][4];
#pragma unroll
    for (int d0 = 0; d0 < 2; ++d0)
#pragma unroll
        for (int ks = 0; ks < 4; ++ks) {
            asm volatile("ds_read_b64_tr_b16 %0,%1 offset:%c2" : "=&v"(lo[d0][ks]) : "v"(vb), "i"(d0 * 4096 + ks * 1024) : "memory");
            asm volatile("ds_read_b64_tr_b16 %0,%1 offset:%c2" : "=&v"(hi[d0][ks]) : "v"(vb), "i"(d0 * 4096 + ks * 1024 + 512) : "memory"); }
#define ATT_PK(d, k) (bf16x8){lo[d][k][0], lo[d][k][1], lo[d][k][2], lo[d][k][3], hi[d][k][0], hi[d][k][1], hi[d][k][2], hi[d][k][3]}
    asm volatile("s_waitcnt lgkmcnt(8)" ::: "memory"); __builtin_amdgcn_sched_barrier(0);
    o[0] = __builtin_amdgcn_mfma_f32_32x32x16_bf16(pa0, ATT_PK(0, 0), o[0], 0, 0, 0);
    o[0] = __builtin_amdgcn_mfma_f32_32x32x16_bf16(pa1, ATT_PK(0, 1), o[0], 0, 0, 0);
    o[0] = __builtin_amdgcn_mfma_f32_32x32x16_bf16(pa2, ATT_PK(0, 2), o[0], 0, 0, 0);
    o[0] = __builtin_amdgcn_mfma_f32_32x32x16_bf16(pa3, ATT_PK(0, 3), o[0], 0, 0, 0);
    asm volatile("s_waitcnt lgkmcnt(0)" ::: "memory"); __builtin_amdgcn_sched_barrier(0);
    o[1] = __builtin_amdgcn_mfma_f32_32x32x16_bf16(pa0, ATT_PK(1, 0), o[1], 0, 0, 0);
    o[1] = __builtin_amdgcn_mfma_f32_32x32x16_bf16(pa1, ATT_PK(1, 1), o[1], 0, 0, 0);
    o[1] = __builtin_amdgcn_mfma_f32_32x32x16_bf16(pa2, ATT_PK(1, 2), o[1], 0, 0, 0);
    o[1] = __builtin_amdgcn_mfma_f32_32x32x16_bf16(pa3, ATT_PK(1, 3), o[1], 0, 0, 0);
#undef ATT_PK
}
__device__ __forceinline__ float half_swap_max(float m) { auto rr = __builtin_amdgcn_permlane32_swap(__float_as_uint(m), __float_as_uint(m), false, false); return fmaxf(__uint_as_float(rr[0]), __uint_as_float(rr[1])); }
__device__ __forceinline__ float half_swap_sum(float m) { auto rr = __builtin_amdgcn_permlane32_swap(__float_as_uint(m), __float_as_uint(m), false, false); return __uint_as_float(rr[0]) + __uint_as_float(rr[1]); }
__device__ __forceinline__ void softmax_pv(f32x16& p0, f32x16& p1, float& m_run, float& l_run, f32x16* o, int vb, LAS float* wsf, int r32, int hi) {
    float mx = p0[0];
#pragma unroll
    for (int r = 1; r < 16; ++r) mx = fmaxf(mx, p0[r]);
#pragma unroll
    for (int r = 0; r < 16; ++r) mx = fmaxf(mx, p1[r]);
    mx = half_swap_max(mx);
    const float mnew = fmaxf(m_run, mx), msafe = (mnew == -INFINITY) ? 0.f : mnew;
    const float alpha = __builtin_amdgcn_exp2f(m_run - msafe);
    m_run = mnew;
    float rs = 0.f;
#pragma unroll
    for (int r = 0; r < 16; ++r) { p0[r] = __builtin_amdgcn_exp2f(p0[r] - msafe); p1[r] = __builtin_amdgcn_exp2f(p1[r] - msafe); rs += p0[r] + p1[r]; }
    l_run = l_run * alpha + rs;
    if (__any(alpha != 1.0f)) {
        if (hi == 0) wsf[r32] = alpha;
        asm volatile("s_waitcnt lgkmcnt(0)" ::: "memory");
#pragma unroll
        for (int g = 0; g < 4; ++g) { const f32x4 a4 = *(const LAS f32x4*)(wsf + 8 * g + 4 * hi);
#pragma unroll
            for (int i = 0; i < 4; ++i) { o[0][4 * g + i] *= a4[i]; o[1][4 * g + i] *= a4[i]; } }
    }
    u32x4 pw0, pw1, pw2, pw3;
    pw0 = (u32x4){cvtpk(p0[0], p0[1]), cvtpk(p0[2], p0[3]), cvtpk(p0[4], p0[5]), cvtpk(p0[6], p0[7])}; pw1 = (u32x4){cvtpk(p0[8], p0[9]), cvtpk(p0[10], p0[11]), cvtpk(p0[12], p0[13]), cvtpk(p0[14], p0[15])};
    pw2 = (u32x4){cvtpk(p1[0], p1[1]), cvtpk(p1[2], p1[3]), cvtpk(p1[4], p1[5]), cvtpk(p1[6], p1[7])}; pw3 = (u32x4){cvtpk(p1[8], p1[9]), cvtpk(p1[10], p1[11]), cvtpk(p1[12], p1[13]), cvtpk(p1[14], p1[15])};
    pv(o, vb, __builtin_bit_cast(bf16x8, pw0), __builtin_bit_cast(bf16x8, pw1), __builtin_bit_cast(bf16x8, pw2), __builtin_bit_cast(bf16x8, pw3));
}
template <class RowOff>
__device__ __forceinline__ void store_o(const f32x16* o, float l_run, LAS float* wsf, LAS bf16_t* stg, bf16_t* Obase, const RowOff& rowoff, int lane, int r32, int hi) {
    const float lt = half_swap_sum(l_run);
    if (hi == 0) wsf[32 + r32] = lt;
    asm volatile("s_waitcnt lgkmcnt(0)" ::: "memory");
    float rli[16];
#pragma unroll
    for (int g = 0; g < 4; ++g) { const f32x4 a4 = *(const LAS f32x4*)(wsf + 32 + 8 * g + 4 * hi);
#pragma unroll
        for (int i = 0; i < 4; ++i) rli[4 * g + i] = __builtin_amdgcn_rcpf(a4[i]); }
#pragma unroll
    for (int r = 0; r < 16; ++r) { const int orow = crow(r, hi);
#pragma unroll
        for (int d0 = 0; d0 < 2; ++d0) stg[orow * 64 + d0 * 32 + r32] = (bf16_t)f2bf(o[d0][r] * rli[r]); }
    asm volatile("s_waitcnt lgkmcnt(0)" ::: "memory");
#pragma unroll
    for (int i = 0; i < 4; ++i) { const int row = i * 8 + (lane >> 3), ch = lane & 7; const u32x4 v = *(const LAS u32x4*)(stg + row * 64 + ch * 8); *(u32x4*)(Obase + rowoff(row) + ch * 8) = v; }
    asm volatile("s_waitcnt lgkmcnt(0)" ::: "memory");
}

typedef short s16x4 __attribute__((ext_vector_type(4)));
constexpr int F_RING = 0, F_KB = 65536, F_WS = 131072 + 64;
constexpr float F_THR = 8.0f;
__device__ __forceinline__ void fox_unit(const Ctx& c, int b, int h, int qb, const bf16_t* QKV, const float* KB3, bf16_t* MER, float kmaxn) {
    const int lane = c.lane, r32 = lane & 31, hi = lane >> 5, wid = c.wave;
    const size_t rowbase = (size_t)b * SEQ; const int q0 = qb * 256, NT = (q0 + 256) / 64;
    const bf16_t* Qw = QKV + (rowbase + q0 + wid * 32) * QKV0_LD + h * 64;
    const bf16_t* Kh = QKV + rowbase * QKV0_LD + 512 + h * 64; const bf16_t* Vh = QKV + rowbase * QKV0_LD + 1024 + h * 64;
    const unsigned lds0 = (unsigned)(size_t)c.lds;
    LAS float* wsf = (LAS float*)(c.lds + F_WS) + wid * 64;
    { const u32x4* src = (const u32x4*)((const u32x2*)KB3 + (size_t)(b * 8 + h) * SEQ); LAS u32x4* dst = (LAS u32x4*)(c.lds + F_KB); for (int i = c.tid; i < NT * 32; i += 512) dst[i] = src[i];
      if (c.tid == 0) *(LAS u32x2*)(c.lds + F_KB + 65536) = (u32x2){0x3f803f80u, 0u}; }
    bf16x8 qr[4];
#pragma unroll
    for (int d0 = 0; d0 < 4; ++d0) qr[d0] = *(const bf16x8*)(Qw + (size_t)r32 * QKV0_LD + d0 * 16 + hi * 8);
    const int krow = wid * 8 + (lane >> 3);
    const bf16_t* ksrc = Kh + (size_t)krow * QKV0_LD + (((lane & 7) ^ ((krow >> 1) & 7)) * 8);
    const bf16_t* vsrc = Vh + (size_t)(16 * (wid & 3) + (lane >> 2)) * QKV0_LD + (wid >> 2) * 32 + (lane & 3) * 8;
    const unsigned kdst = lds0 + F_RING + wid * 1024, vdst = lds0 + F_RING + 8192 + wid * 1024;
#define FOX_DMA(t, slot) do { glds16(ksrc + (size_t)(t) * 64 * QKV0_LD, (unsigned)__builtin_amdgcn_readfirstlane(kdst + (slot) * 16384)); glds16(vsrc + (size_t)(t) * 64 * QKV0_LD, (unsigned)__builtin_amdgcn_readfirstlane(vdst + (slot) * 16384)); } while (0)
#define FOX_KLOAD(slot) do { const LAS unsigned char* kb_ = c.lds + F_RING + (slot) * 16384; \
        _Pragma("unroll") for (int d0 = 0; d0 < 4; ++d0) { kf[2 * d0] = *(const LAS bf16x8*)(kb_ + kimg(r32, 2 * d0 + hi)); kf[2 * d0 + 1] = *(const LAS bf16x8*)(kb_ + 4096 + kimg(r32, 2 * d0 + hi)); } } while (0)
    const int vb0 = (int)(lds0 + F_RING + 8192) + ((lane >> 4) & 1) * 32 + (lane & 3) * 8 + (4 * hi + ((lane & 15) >> 2)) * 64;
    {
        u32x4 q0_ = __builtin_bit_cast(u32x4, qr[0]), q1_ = __builtin_bit_cast(u32x4, qr[1]), q2_ = __builtin_bit_cast(u32x4, qr[2]), q3_ = __builtin_bit_cast(u32x4, qr[3]);
        asm volatile("" : "+v"(q0_), "+v"(q1_), "+v"(q2_), "+v"(q3_));
        qr[0] = __builtin_bit_cast(bf16x8, q0_); qr[1] = __builtin_bit_cast(bf16x8, q1_); qr[2] = __builtin_bit_cast(bf16x8, q2_); qr[3] = __builtin_bit_cast(bf16x8, q3_); }
    int ts;
    { float qn = 0.f;
#pragma unroll
      for (int d0 = 0; d0 < 4; ++d0) { const u32x4 w_ = __builtin_bit_cast(u32x4, qr[d0]);
#pragma unroll
          for (int e = 0; e < 4; ++e) { const float lo_ = bf2f((unsigned short)(w_[e] & 0xffffu)), hi_ = bf2f((unsigned short)(w_[e] >> 16)); qn += lo_ * lo_ + hi_ * hi_; } }
      float sqq = 0.f; { const bf16_t* kq = Kh + (size_t)(q0 + wid * 32 + r32) * QKV0_LD + hi * 8;
#pragma unroll
        for (int d0 = 0; d0 < 4; ++d0) { const u32x4 w_ = __builtin_bit_cast(u32x4, qr[d0]), k_ = *(const u32x4*)(kq + d0 * 16);
#pragma unroll
            for (int e = 0; e < 4; ++e) sqq += bf2f((unsigned short)(w_[e] & 0xffffu)) * bf2f((unsigned short)(k_[e] & 0xffffu)) + bf2f((unsigned short)(w_[e] >> 16)) * bf2f((unsigned short)(k_[e] >> 16)); } }
      qn = half_swap_sum(qn); sqq = half_swap_sum(sqq);
      asm volatile("s_waitcnt vmcnt(0) lgkmcnt(0)\n\ts_barrier" ::: "memory");
      const LAS u32x2* kbp = (const LAS u32x2*)(c.lds + F_KB);
#define FOX_KBV(k_) ({ const u32x2 w_ = kbp[(k_)]; bf2f((unsigned short)(w_.x & 0xffffu)) + bf2f((unsigned short)(w_.x >> 16)) + bf2f((unsigned short)(w_.y & 0xffffu)); })
      float lq = sqq + FOX_KBV(q0 + wid * 32 + r32);
#pragma unroll
      for (int o_ = 1; o_ < 32; o_ <<= 1) { qn = fmaxf(qn, __shfl_xor(qn, o_)); lq = fminf(lq, __shfl_xor(lq, o_)); }
      LAS float* qm = (LAS float*)(c.lds + F_WS + 2048);
      if (lane == 0) { qm[wid] = qn; qm[8 + wid] = lq; }
      asm volatile("s_waitcnt lgkmcnt(0)\n\ts_barrier" ::: "memory");
      float qmax = qm[0], lmin = qm[8];
#pragma unroll
      for (int w_ = 1; w_ < 8; ++w_) { qmax = fmaxf(qmax, qm[w_]); lmin = fminf(lmin, qm[8 + w_]); }
      const float thr = lmin - 42.f - sqrtf(qmax) * kmaxn;
      int lo_ = 0, hi_ = 4 * qb;
#pragma unroll 1
      for (int it = 0; it < 8; ++it) { const int mid = (lo_ + hi_ + 1) >> 1; const bool okc = (mid == 0) || (FOX_KBV(64 * mid - 1) <= thr); lo_ = okc ? mid : lo_; hi_ = okc ? hi_ : mid - 1; }
#undef FOX_KBV
      ts = __builtin_amdgcn_readfirstlane(lo_); }
    asm volatile("s_waitcnt vmcnt(0)" ::: "memory");
    FOX_DMA(ts, 0); FOX_DMA(ts + 1, 1); FOX_DMA(ts + 2, 2);
    float mhat = 0.f, l_run = 0.f; f32x16 o[2]; o[0] = f32x16{}; o[1] = f32x16{};
    s16x4 qside = hi ? (s16x4){0, 0, 0, 0} : (s16x4){(short)0x3f80, (short)0x3f80, (short)0x3f80, 0};
    const int qrel = wid * 32 + r32;
    bf16x8 kf[8];
    const bool late = wid >= 4;
    asm volatile("s_waitcnt vmcnt(4) lgkmcnt(0)\n\ts_barrier" ::: "memory");
    int slot = 0;
    const LAS unsigned char* kbrd = c.lds + F_KB + (hi ? 65536 : r32 * 8 + ts * 512);
    const int kbstep = hi ? 0 : 512;
    f32x16 p0, p1;
#define FOX_QK(t_) do { __builtin_amdgcn_s_setprio(1); \
        p0 = __builtin_amdgcn_mfma_f32_32x32x16_bf16(kf[0], qr[0], f32x16{}, 0, 0, 0); p1 = __builtin_amdgcn_mfma_f32_32x32x16_bf16(kf[1], qr[0], f32x16{}, 0, 0, 0); \
        _Pragma("unroll") for (int d0 = 1; d0 < 4; ++d0) { p0 = __builtin_amdgcn_mfma_f32_32x32x16_bf16(kf[2 * d0], qr[d0], p0, 0, 0, 0); p1 = __builtin_amdgcn_mfma_f32_32x32x16_bf16(kf[2 * d0 + 1], qr[d0], p1, 0, 0, 0); } \
        { const s16x4 b0 = *(const LAS s16x4*)(kbrd), b1 = *(const LAS s16x4*)(kbrd + (hi ? 0 : 256)); kbrd += kbstep; \
          p0 = __builtin_amdgcn_mfma_f32_32x32x8bf16_1k(b0, qside, p0, 0, 0, 0); p1 = __builtin_amdgcn_mfma_f32_32x32x8bf16_1k(b1, qside, p1, 0, 0, 0); } __builtin_amdgcn_s_setprio(0); } while (0)
#define FOX_TOP(t_) do { if ((t_) + 2 < NT) asm volatile("s_waitcnt vmcnt(2) lgkmcnt(0)\n\ts_barrier" ::: "memory"); else asm volatile("s_waitcnt vmcnt(0) lgkmcnt(0)\n\ts_barrier" ::: "memory");     \
        if ((t_) + 3 < NT) { const int s3 = (slot + 3) & 3; FOX_DMA((t_) + 3, s3); } } while (0)
#define FOX_SOFTMAX_PV(t_) do { \
        const int jb = (t_) - (NT - 4); \
        if (jb >= 0) { const int kb = 64 * jb + 4 * hi; \
            _Pragma("unroll") for (int r = 0; r < 16; ++r) { const int kv = kb + (r & 3) + 8 * (r >> 2); if (kv > qrel) p0[r] = -INFINITY; if (kv + 32 > qrel) p1[r] = -INFINITY; } } \
        float mx = p0[0]; \
        _Pragma("unroll") for (int r = 1; r < 16; ++r) mx = fmaxf(mx, p0[r]); \
        _Pragma("unroll") for (int r = 0; r < 16; ++r) mx = fmaxf(mx, p1[r]); \
        mx = half_swap_max(mx); \
        if ((t_) == ts || __any(mx > F_THR)) {            \
            float dl = ((t_) == ts) ? mx : fmaxf(mx, 0.f); \
            const float mnew = mhat + dl; const unsigned mh = f2bf(mnew); const float r1 = mnew - bf2f((unsigned short)mh); const unsigned ml = f2bf(r1); const float mq = bf2f((unsigned short)mh) + bf2f((unsigned short)ml); \
            dl = mq - mhat; mhat = mq; \
            if (hi) { qside[0] = (short)(mh ^ 0x8000u); qside[1] = (short)(ml ^ 0x8000u); } \
            _Pragma("unroll") for (int r = 0; r < 16; ++r) { p0[r] -= dl; p1[r] -= dl; } \
            const float f = __builtin_amdgcn_exp2f(-dl); l_run *= f; \
            if (hi == 0) wsf[r32] = f; \
            asm volatile("s_waitcnt lgkmcnt(0)" ::: "memory"); \
            _Pragma("unroll") for (int g = 0; g < 4; ++g) { const f32x4 a4 = *(const LAS f32x4*)(wsf + 8 * g + 4 * hi); \
                _Pragma("unroll") for (int i = 0; i < 4; ++i) { o[0][4 * g + i] *= a4[i]; o[1][4 * g + i] *= a4[i]; } } \
        } \
        float rs = 0.f; \
        _Pragma("unroll") for (int r = 0; r < 16; ++r) { p0[r] = __builtin_amdgcn_exp2f(p0[r]); p1[r] = __builtin_amdgcn_exp2f(p1[r]); rs += p0[r] + p1[r]; } \
        l_run += rs; \
        u32x4 pw0, pw1, pw2, pw3; \
        pw0 = (u32x4){cvtpk(p0[0], p0[1]), cvtpk(p0[2], p0[3]), cvtpk(p0[4], p0[5]), cvtpk(p0[6], p0[7])}; pw1 = (u32x4){cvtpk(p0[8], p0[9]), cvtpk(p0[10], p0[11]), cvtpk(p0[12], p0[13]), cvtpk(p0[14], p0[15])}; \
        pw2 = (u32x4){cvtpk(p1[0], p1[1]), cvtpk(p1[2], p1[3]), cvtpk(p1[4], p1[5]), cvtpk(p1[6], p1[7])}; pw3 = (u32x4){cvtpk(p1[8], p1[9]), cvtpk(p1[10], p1[11]), cvtpk(p1[12], p1[13]), cvtpk(p1[14], p1[15])}; \
        pv(o, vb0 + slot * 16384, __builtin_bit_cast(bf16x8, pw0), __builtin_bit_cast(bf16x8, pw1), __builtin_bit_cast(bf16x8, pw2), __builtin_bit_cast(bf16x8, pw3)); } while (0)
#pragma unroll 1
    for (int t = ts; t < NT; ++t) {
        if (!late) FOX_TOP(t);
        FOX_KLOAD(slot); FOX_QK(t);
        if (late) FOX_TOP(t);
        FOX_SOFTMAX_PV(t);
        slot = (slot + 1) & 3;
    }
#undef FOX_QK
#undef FOX_TOP
#undef FOX_SOFTMAX_PV
#undef FOX_DMA
#undef FOX_KLOAD
    asm volatile("s_waitcnt lgkmcnt(0)\n\ts_barrier" ::: "memory");
    bf16_t* Ow = MER + (rowbase + q0 + wid * 32) * MER_LD + h * 64;
    store_o(o, l_run, wsf, (LAS bf16_t*)(c.lds + F_RING) + wid * 2048, Ow, [](int row) { return (size_t)row * MER_LD; }, lane, r32, hi);
    asm volatile("s_waitcnt vmcnt(0) lgkmcnt(0)\n\ts_barrier" ::: "memory");
}
__device__ __forceinline__ void fox_scan(const Ctx& c, const float* LF, float* KB2, int bh) {
    LAS float* part = (LAS float*)(c.lds + 140 * 1024);
    const float* src = LF + (size_t)bh * SEQ + c.tid * 16; float v[16];
#pragma unroll
    for (int i = 0; i < 4; ++i) { const f32x4 q = ((const f32x4*)src)[i]; v[4 * i] = q.x; v[4 * i + 1] = q.y; v[4 * i + 2] = q.z; v[4 * i + 3] = q.w; }
#pragma unroll
    for (int i = 1; i < 16; ++i) v[i] += v[i - 1];
    part[c.tid] = v[15];
    __syncthreads();
    if (c.tid < 64) { float s[8]; float run = 0.f;
#pragma unroll
        for (int i = 0; i < 8; ++i) { run += part[c.tid * 8 + i]; s[i] = run; }
        float inc = run;
#pragma unroll
        for (int o = 1; o < 64; o <<= 1) { const float u = __shfl_up(inc, o); if (c.lane >= o) inc += u; }
        const float base = inc - run;
#pragma unroll
        for (int i = 0; i < 8; ++i) part[c.tid * 8 + i] = base + s[i]; }
    __syncthreads();
    const float off = (c.tid > 0) ? part[c.tid - 1] : 0.f;
    u32x2* dst = (u32x2*)KB2 + (size_t)bh * SEQ + c.tid * 16;
#pragma unroll
    for (int i = 0; i < 16; ++i) { const float kb = -LOG2E * (v[i] + off); const unsigned h1 = f2bf(kb); const float r1 = kb - bf2f((unsigned short)h1); const unsigned h2 = f2bf(r1); const float r2 = r1 - bf2f((unsigned short)h2); const unsigned h3 = f2bf(r2);
        u32x2 w; w.x = h1 | (h2 << 16); w.y = h3; dst[i] = w; }
    __syncthreads();
}

constexpr int D_TILE = 0, D_TB = 131072, D_WS = 131072 + 6400;
__device__ __forceinline__ float t5_bucket_f(int dist) { if (dist < 16) return (float)dist; const int l = 16 + (int)(logf((float)dist * (1.0f / 16.0f)) / logf(128.0f) * 16.0f); return (float)(l < 31 ? l : 31); }
__device__ __forceinline__ void dil_tables(const Ctx& c, const float* relb) {
    LAS float* TB = (LAS float*)(c.lds + D_TB);
    for (int i = c.tid; i < 12 * 131; i += 512) { const int hd = i / 131, n = i % 131 - 1, g = hd >> 2; const int r = (g == 0) ? 1 : (g == 1 ? 4 : 16);
        TB[hd * 132 + 1 + n] = (n < 0 || n > 128) ? -INFINITY : relb[(int)t5_bucket_f(r * n) * 16 + hd] * LOG2E; }
    __syncthreads();
}
__device__ __forceinline__ void dil_unit(const Ctx& c, int u, const bf16_t* QKV, bf16_t* MER) {
    const int lane = c.lane, r32 = lane & 31, hi = lane >> 5, wid = c.wave;
    const int mb = u & 15, cc = (u >> 4) & 15, j = (u >> 8) & 3, b = u >> 10, m0 = mb * 32;
    const size_t rowbase = (size_t)b * SEQ;
    const unsigned lds0 = (unsigned)(size_t)c.lds;
    LAS unsigned char* tile = c.lds + D_TILE + wid * 16384;
    const unsigned tile0 = lds0 + D_TILE + wid * 16384;
    LAS float* wsf = (LAS float*)(c.lds + D_WS) + wid * 64;
    const LAS float* TB = (const LAS float*)(c.lds + D_TB);
    const int vb0 = (int)tile0 + ((lane >> 4) & 1) * 32 + (lane & 3) * 8 + (4 * hi + ((lane & 15) >> 2)) * 64;
    const int tq = 16 * (m0 + r32) + cc;
    float m_run = -INFINITY, l_run = 0.f; f32x16 o[2]; o[0] = f32x16{}; o[1] = f32x16{};
#pragma unroll 1
    for (int g = 0; g < 3; ++g) {
        const int r = (g == 0) ? 1 : (g == 1 ? 4 : 16), lr = (g == 0) ? 0 : (g == 1 ? 2 : 4), sr = 16 >> lr, cr = cc & (r - 1), hd = g * 4 + j;
        const bf16_t* Qh = QKV + rowbase * QKV0_LD + 1536 + hd * 64; const bf16_t* Kh = QKV + rowbase * QKV0_LD + 2304 + hd * 64; const bf16_t* Vh = QKV + rowbase * QKV0_LD + 3072 + hd * 64;
        bf16x8 qr[4];
#pragma unroll
        for (int d0 = 0; d0 < 4; ++d0) qr[d0] = *(const bf16x8*)(Qh + (size_t)tq * QKV0_LD + d0 * 16 + hi * 8);
        const int uq = (tq - cr) >> lr;
        const int u0 = ((16 * m0 + cc - cr) >> lr) - 128;
        const int nk = 128 + 31 * sr + 1, ntile = (nk + 63) >> 6;
        const LAS float* tb = TB + hd * 132;
#define DIL_KEYTOK(uk_) ({ int uk__ = (uk_); uk__ = uk__ < 0 ? 0 : uk__; int tk__ = (uk__ << lr) + cr; tk__ > SEQ - 1 ? SEQ - 1 : tk__; })
#define DIL_LOADK(dst, t_) do { const int ub_ = u0 + 64 * (t_); const bf16_t* k0_ = Kh + (size_t)DIL_KEYTOK(ub_ + r32) * QKV0_LD + hi * 8; const bf16_t* k1_ = Kh + (size_t)DIL_KEYTOK(ub_ + 32 + r32) * QKV0_LD + hi * 8; \
            _Pragma("unroll") for (int d0 = 0; d0 < 4; ++d0) { dst[2 * d0] = *(const bf16x8*)(k0_ + 16 * d0); dst[2 * d0 + 1] = *(const bf16x8*)(k1_ + 16 * d0); } } while (0)
#define DIL_DMAV(t_) do { const int ub_ = u0 + 64 * (t_); _Pragma("unroll") for (int w = 0; w < 8; ++w) { const int tk_ = DIL_KEYTOK(ub_ + 16 * (w & 3) + (lane >> 2)); \
            __builtin_amdgcn_global_load_lds((const unsigned*)(Vh + (size_t)tk_ * QKV0_LD + (w >> 2) * 32 + (lane & 3) * 8), (LAS unsigned*)(tile + ((t_) & 1) * 8192 + w * 1024), 16, 0, 0); } } while (0)
#define DIL_TILE(kf_, t_) do { const int ub = u0 + 64 * (t_); \
            f32x16 p0 = f32x16{}, p1 = f32x16{}; \
            _Pragma("unroll") for (int d0 = 0; d0 < 4; ++d0) { p0 = __builtin_amdgcn_mfma_f32_32x32x16_bf16(kf_[2 * d0], qr[d0], p0, 0, 0, 0); p1 = __builtin_amdgcn_mfma_f32_32x32x16_bf16(kf_[2 * d0 + 1], qr[d0], p1, 0, 0, 0); } \
            const int nb = uq - ub - 4 * hi; \
            _Pragma("unroll") for (int rr = 0; rr < 16; ++rr) { const int kc = (rr & 3) + 8 * (rr >> 2);            \
                p0[rr] += tb[max(-1, min(nb - kc, 129)) + 1]; p1[rr] += tb[max(-1, min(nb - kc - 32, 129)) + 1]; } \
            if (ub < 0) {            \
                _Pragma("unroll") for (int rr = 0; rr < 16; ++rr) { const int kv = crow(rr, hi); p0[rr] = (ub + kv >= 0) ? p0[rr] : -INFINITY; p1[rr] = (ub + kv + 32 >= 0) ? p1[rr] : -INFINITY; } } \
            softmax_pv(p0, p1, m_run, l_run, o, vb0 + ((t_) & 1) * 8192, wsf, r32, hi); } while (0)
        bf16x8 kfa[8], kfb[8];
        asm volatile("s_waitcnt lgkmcnt(0)" ::: "memory");
        DIL_DMAV(0); DIL_LOADK(kfa, 0);
#pragma unroll 1
        for (int t = 0; t < ntile; t += 2) {
            if (t + 1 < ntile) { asm volatile("s_waitcnt lgkmcnt(0)" ::: "memory"); DIL_DMAV(t + 1); DIL_LOADK(kfb, t + 1); asm volatile("s_waitcnt vmcnt(16)" ::: "memory"); } else asm volatile("s_waitcnt vmcnt(0)" ::: "memory");
            DIL_TILE(kfa, t);
            if (t + 1 < ntile) {
                if (t + 2 < ntile) { asm volatile("s_waitcnt lgkmcnt(0)" ::: "memory"); DIL_DMAV(t + 2); DIL_LOADK(kfa, t + 2); asm volatile("s_waitcnt vmcnt(16)" ::: "memory"); } else asm volatile("s_waitcnt vmcnt(0)" ::: "memory");
                DIL_TILE(kfb, t + 1);
            }
        }
#undef DIL_KEYTOK
#undef DIL_LOADK
#undef DIL_DMAV
#undef DIL_TILE
    }
    asm volatile("s_waitcnt lgkmcnt(0)" ::: "memory");
    bf16_t* Ob = MER + (rowbase + 16 * m0 + cc) * MER_LD + 512 + j * 64;
    store_o(o, l_run, wsf, (LAS bf16_t*)tile, Ob, [](int row) { return (size_t)row * 16 * MER_LD; }, lane, r32, hi);
}
}
namespace dsa {
typedef _Float16 f16x8 __attribute__((ext_vector_type(8)));
using att::glds16;
constexpr float FP8_SCK = 16.f;
__device__ __forceinline__ void ckv_norm(const Ctx& c, const bf16_t* CKV, const float* g, unsigned char* CKVN) {
    const f32x4 gv = *((const f32x4*)g + c.lane);
    for (int row0 = (c.vcu * 8 + c.wave) * 4; row0 < NTOK; row0 += c.G * 8 * 4) {
        u32x2 y[4];
#pragma unroll
        for (int r = 0; r < 4; ++r) y[r] = *((const u32x2*)(CKV + (size_t)(row0 + r) * 256) + c.lane);
#pragma unroll
        for (int r = 0; r < 4; ++r) {
            f32x4 v; v.x = __builtin_bit_cast(float, y[r].x << 16); v.y = __builtin_bit_cast(float, y[r].x & 0xffff0000u); v.z = __builtin_bit_cast(float, y[r].y << 16); v.w = __builtin_bit_cast(float, y[r].y & 0xffff0000u);
            const float rs = 1.0f / sqrtf(wave_sum(dot4(v, v)) * (1.0f / 256.0f) + EPS);
            v = (v * rs) * gv;
            *((unsigned*)(CKVN + (size_t)(row0 + r) * 256) + c.lane) = pk4_fp8(v.x * FP8_SCK, v.y * FP8_SCK, v.z * FP8_SCK, v.w * FP8_SCK); }
    }
}
constexpr int NBIN = 512, CAP = 96;
constexpr int X_K = 0, X_H = 24576, X_BM = X_H, X_CAND = X_H + 65536, X_LS = X_CAND + 64 * CAP * 8, X_ROW = X_H + 131072, X_RED = X_ROW + 2048;
typedef _Float16 f16x2 __attribute__((ext_vector_type(2)));

__device__ __forceinline__ void idx_boundary(const Ctx& c) {
    const int lane = c.lane, wid = c.wave;
    LAS unsigned* HIST = (LAS unsigned*)(c.lds + X_H);
    LAS float* RLO = (LAS float*)(c.lds + X_ROW); LAS int* RBST = (LAS int*)(RLO + 128); LAS int* RNEED = (LAS int*)(RLO + 192);
    asm volatile("s_waitcnt lgkmcnt(0)" ::: "memory");
#pragma unroll 1
    for (int r = 0; r < 8; ++r) { const int rowl = wid * 8 + r; int cn[8]; int tot = 0;
        { const u32x4 h0 = *((const LAS u32x4*)(HIST + rowl * NBIN) + 2 * lane), h1 = *((const LAS u32x4*)(HIST + rowl * NBIN) + 2 * lane + 1);
          cn[0] = h0.x; cn[1] = h0.y; cn[2] = h0.z; cn[3] = h0.w; cn[4] = h1.x; cn[5] = h1.y; cn[6] = h1.z; cn[7] = h1.w; }
#pragma unroll
        for (int i = 0; i < 8; ++i) tot += cn[i];
        int suf = tot;
#pragma unroll
        for (int o = 1; o < 64; o <<= 1) { const int v = __shfl_down(suf, o); if (lane + o < 64) suf += v; }
        const int above_me = suf - tot;
        if (above_me < 256 && suf >= 256) { int acc = above_me, bb = 0, na = 0; bool found = false;
#pragma unroll
            for (int i = 7; i >= 0; --i) { if (!found) { if (acc + cn[i] >= 256) { bb = lane * 8 + i; na = acc; found = true; } else acc += cn[i]; } }
            RBST[rowl] = bb; RNEED[rowl] = 256 - na; }
    }
    asm volatile("s_waitcnt lgkmcnt(0)" ::: "memory");
}
template <int PASS, bool DIAG, int MODE = 0>
__device__ __forceinline__ void idx_tile(const Ctx& c, int t, unsigned long long* SCw, f16x8 (&bfr)[2][4], const _Float16* knext, const f16x8 (&af)[2][4], const f16x8 (&wa)[4], const f16x2 (&rv)[2], const f16x2 (&nl)[2], const int (&cut)[4]) {
    const int lane = c.lane, n32 = lane & 31, hi = lane >> 5, wid = c.wave;
    LAS unsigned* HIST = (LAS unsigned*)(c.lds + X_H);
    f32x16 s4[2];
#pragma unroll
    for (int H = 0; H < 2; ++H) {
        f32x16 d[2];
#pragma unroll
        for (int T = 0; T < 2; ++T) { d[T] = f32x16{};
#pragma unroll
            for (int ks = 0; ks < 4; ++ks) d[T] = __builtin_amdgcn_mfma_f32_32x32x16_f16(af[T][ks], bfr[H][ks], d[T], 0, 0, 0); }
        if (knext && !(MODE & 2)) {
#pragma unroll
            for (int ks = 0; ks < 4; ++ks) bfr[H][ks] = *(const f16x8*)(knext + (ks * 1024 + H * 256 - 2048)); }
        s4[H] = f32x16{};
#pragma unroll
        for (int s = 0; s < 4; ++s) {
            f16x8 rb;
#pragma unroll
            for (int j2 = 0; j2 < 4; ++j2) { const f16x2 z = {(_Float16)0.f, (_Float16)0.f}; f16x2 pr = __builtin_bit_cast(f16x2, __builtin_amdgcn_cvt_pkrtz(d[s >> 1][8 * (s & 1) + 2 * j2], d[s >> 1][8 * (s & 1) + 2 * j2 + 1]));
                pr = __builtin_elementwise_max(pr, z); rb[2 * j2] = pr[0]; rb[2 * j2 + 1] = pr[1]; }
            s4[H] = __builtin_amdgcn_mfma_f32_32x32x16_f16(wa[s], rb, s4[H], 0, 0, 0); }
        }
#pragma unroll
    for (int H = 0; H < 2; ++H) {
        const unsigned w0 = __builtin_bit_cast(unsigned, __builtin_amdgcn_cvt_pkrtz(s4[H][0], s4[H][1])), w1 = __builtin_bit_cast(unsigned, __builtin_amdgcn_cvt_pkrtz(s4[H][2], s4[H][3]));
        if (!(MODE & 4)) SCw[(size_t)(2 * t + H) * 512] = (unsigned long long)w0 | ((unsigned long long)w1 << 32);
        const f16x2 lo2 = {(_Float16)1024.f, (_Float16)1024.f}, hi2 = {(_Float16)1535.f, (_Float16)1535.f};
        unsigned bw[2];
#pragma unroll
        for (int p = 0; p < 2; ++p) { f16x2 v = __builtin_elementwise_fma(__builtin_bit_cast(f16x2, p ? w1 : w0), rv[p], nl[p]); v = __builtin_elementwise_min(__builtin_elementwise_max(v, lo2), hi2); bw[p] = __builtin_bit_cast(unsigned, v); }
        const int kloc = 32 * H + n32;
#pragma unroll
        for (int i = 0; i < 4; ++i) {
            const int rowl = wid * 8 + 4 * hi + i; const int bin = (i & 1) ? (int)((bw[i >> 1] >> 16) & 0x3FFu) : (int)(bw[i >> 1] & 0x3FFu);
            const bool cnt = (!DIAG || (kloc <= rowl)) && bin >= cut[i];
            if (cnt && !(MODE & 1)) __hip_atomic_fetch_add(HIST + rowl * NBIN + bin, 1u, __ATOMIC_RELAXED, __HIP_MEMORY_SCOPE_WORKGROUP);
            if (MODE & 1) asm volatile("" :: "v"(bin));
        }
    }
}
__device__ __forceinline__ int idx_bin(unsigned hb, _Float16 rv, _Float16 nl) {
    _Float16 v = __builtin_fmaf16(__builtin_bit_cast(_Float16, (unsigned short)hb), rv, nl); v = __builtin_fminf16(__builtin_fmaxf16(v, (_Float16)1024.f), (_Float16)1535.f);
    return (int)(__builtin_bit_cast(unsigned short, v) & 0x3FFu);
}
template <int PASS, int MODE = 0>
__device__ __forceinline__ void idx_tiles(const Ctx& c, int NT, unsigned long long* SCw, const _Float16* kt0, const f16x8 (&af)[2][4], const f16x8 (&wa)[4], const f16x2 (&rv)[2], const f16x2 (&nl)[2]) {
    const int lane = c.lane, n32 = lane & 31, hi = lane >> 5, wid = c.wave;
    const _Float16* kp = kt0 + 2048 + hi * 512 + n32 * 8;
#define IDX_LOADB(dst, t) do { _Pragma("unroll") for (int H = 0; H < 2; ++H) _Pragma("unroll") for (int ks = 0; ks < 4; ++ks) dst[H][ks] = *(const f16x8*)(kp + (size_t)(t) * 4096 + (ks * 1024 + H * 256 - 2048)); } while (0)
    int cut[4] = {0, 0, 0, 0};
    f16x8 b0[2][4];
    IDX_LOADB(b0, 0);
#pragma unroll 1
    for (int t = 0; t < NT - 1; ++t) {
        idx_tile<PASS, false, MODE>(c, t, SCw, b0, kp + (size_t)(t + 1) * 4096, af, wa, rv, nl, cut);
        if (PASS == 0 && MODE == 0 && t == 31 && t + 8 < NT) {
            idx_boundary(c);
            LAS int* RBST = (LAS int*)((LAS float*)(c.lds + X_ROW) + 128);
#pragma unroll
            for (int i = 0; i < 4; ++i) cut[i] = RBST[wid * 8 + 4 * hi + i];
        }
    }
    if (MODE == 0) idx_tile<PASS, true>(c, NT - 1, SCw, b0, nullptr, af, wa, rv, nl, cut);
#undef IDX_LOADB
}

template <bool DIAG>
__device__ __forceinline__ void idx_emit_tile(const Ctx& c, int t, const unsigned long long (&cur)[2], const unsigned (&thi)[8], const unsigned (&tlo)[8], int (&ca)[8], int (&cc)[8]) {
    const int lane = c.lane, wid = c.wave;
    LAS unsigned short* LIST = (LAS unsigned short*)(c.lds + X_BM); LAS unsigned* CANDC = (LAS unsigned*)(c.lds + X_CAND);
#pragma unroll
    for (int g = 0; g < 2; ++g)
#pragma unroll
        for (int i = 0; i < 4; ++i) {
            const int r = 4 * g + i, rowl = wid * 8 + r; const unsigned hb = (unsigned)(cur[g] >> (16 * i)) & 0xFFFFu; const _Float16 x = __builtin_bit_cast(_Float16, (unsigned short)hb);
            const bool ok = !DIAG || (lane <= rowl);
            const bool above = ok && (x >= __builtin_bit_cast(_Float16, (unsigned short)thi[r])), ge = ok && (x >= __builtin_bit_cast(_Float16, (unsigned short)tlo[r]));
            const unsigned long long ma = __ballot(above), me = __ballot(ge) & ~ma;
            if (above) { const int p = (int)__builtin_amdgcn_mbcnt_hi((unsigned)(ma >> 32), __builtin_amdgcn_mbcnt_lo((unsigned)ma, (unsigned)ca[r])); if (p < 256) LIST[rowl * 256 + p] = (unsigned short)(64 * t + lane); }
            ca[r] += __popcll(ma);
            if (me != 0ull) {
                if (ge && !above) { const int p = (int)__builtin_amdgcn_mbcnt_hi((unsigned)(me >> 32), __builtin_amdgcn_mbcnt_lo((unsigned)me, (unsigned)cc[r]));
                    if (p < CAP) { const unsigned h0 = (hb == 0x8000u) ? 0u : hb; const unsigned neg = (unsigned)((int)(h0 << 16) >> 31);
                        CANDC[rowl * CAP + p] = ((h0 ^ (0x8000u | (neg & 0x7FFFu))) << 16) | (0xFFFFu - (unsigned)(64 * t + lane)); } }
                cc[r] += __popcll(me);
            }
        }
}
__device__ __forceinline__ void idx_emit(const Ctx& c, int NT, const unsigned long long* SCblk, const unsigned (&thi)[8], const unsigned (&tlo)[8]) {
    const int lane = c.lane, wid = c.wave;
    LAS int* CCNT = (LAS int*)(c.lds + X_RED) + 64; LAS int* CABV = (LAS int*)(c.lds + X_RED) + 128;
    const unsigned long long* rp = SCblk + wid * 64 + (lane >> 5) * 512 + (lane & 31);
    int cc[8], ca[8];
#pragma unroll
    for (int r = 0; r < 8; ++r) { cc[r] = 0; ca[r] = 0; }
    unsigned long long cur[2], nxt[2];
#pragma unroll
    for (int g = 0; g < 2; ++g) cur[g] = __hip_atomic_load(rp + g * 32, __ATOMIC_RELAXED, __HIP_MEMORY_SCOPE_AGENT);
#pragma unroll 1
    for (int t = 0; t < NT - 1; ++t) {
#pragma unroll
        for (int g = 0; g < 2; ++g) nxt[g] = __hip_atomic_load(rp + (size_t)(t + 1) * 1024 + g * 32, __ATOMIC_RELAXED, __HIP_MEMORY_SCOPE_AGENT);
        idx_emit_tile<false>(c, t, cur, thi, tlo, ca, cc);
        cur[0] = nxt[0]; cur[1] = nxt[1];
    }
    idx_emit_tile<true>(c, NT - 1, cur, thi, tlo, ca, cc);
    if (lane == 0) {
#pragma unroll
        for (int r = 0; r < 8; ++r) { CCNT[wid * 8 + r] = cc[r]; CABV[wid * 8 + r] = ca[r]; } }
}
__device__ __forceinline__ void idx_unit(const Ctx& c, int b, int qb, const bf16_t* QI, const bf16_t* KI, const float* WI, unsigned short* SEL, unsigned long long* SCblk) {
    int lane = c.lane; asm volatile("" : "+v"(lane));
    const int n32 = lane & 31, hi = lane >> 5, wid = c.wave, tid = wid * 64 + lane;
    const size_t rowbase = (size_t)b * SEQ; const int q0 = qb * 64, NT = qb + 1;
    if (qb < 4) {
        for (int r = 0; r < 8; ++r) { unsigned short* dst = SEL + (rowbase + q0 + wid * 8 + r) * 256;
#pragma unroll
            for (int i = 0; i < 4; ++i) dst[lane + 64 * i] = (unsigned short)(lane + 64 * i); }
        return;
    }
    const unsigned lds0 = (unsigned)(size_t)c.lds;
    LAS unsigned* HIST = (LAS unsigned*)(c.lds + X_H); LAS unsigned* BM = (LAS unsigned*)(c.lds + X_BM);
    LAS float* CANDS = (LAS float*)(c.lds + X_CAND); LAS int* CANDI = (LAS int*)(c.lds + X_CAND + 64 * CAP * 4);
    LAS float* RLO = (LAS float*)(c.lds + X_ROW); LAS float* RINV = RLO + 64; LAS int* RBST = (LAS int*)(RLO + 128); LAS int* RNEED = (LAS int*)(RLO + 192);
    LAS float* RED = (LAS float*)(c.lds + X_RED); LAS int* CCNT = (LAS int*)(c.lds + X_RED) + 64;
    const _Float16* KIh = (const _Float16*)KI + rowbase * 64; const _Float16* QIh = (const _Float16*)QI;
    float kmax = 0.f;
#ifdef PROBE_KMAX2
    for (int rep_ = 0; rep_ < 2; ++rep_)
#endif
    for (int k = tid; k < NT * 64; k += 512) { const _Float16* kp = KIh + (size_t)(k >> 6) * 4096 + (k & 63) * 8; float s = 0.f;
#pragma unroll
        for (int i = 0; i < 8; ++i) { const f16x8 v = *(const f16x8*)(kp + i * 512);
#pragma unroll
            for (int e = 0; e < 8; ++e) s += (float)v[e] * (float)v[e]; }
        kmax = fmaxf(kmax, s); }
#pragma unroll
    for (int o = 1; o < 64; o <<= 1) kmax = fmaxf(kmax, __shfl_xor(kmax, o));
    if (lane == 0) RED[wid] = kmax;
    for (int i = tid; i < 64 * NBIN; i += 512) HIST[i] = 0u;
    if (tid < 64) CCNT[tid] = 0;
    __syncthreads();
    kmax = RED[0];
#pragma unroll
    for (int w = 1; w < 8; ++w) kmax = fmaxf(kmax, RED[w]);
    kmax = sqrtf(kmax);
    { const int qw = lane >> 3, h = lane & 7; const size_t qrow = rowbase + q0 + wid * 8 + qw; const f16x8* qp = (const f16x8*)(QIh + qrow * 512 + h * 64); float s = 0.f;
#pragma unroll
      for (int i = 0; i < 8; ++i) { const f16x8 v = qp[i];
#pragma unroll
          for (int e = 0; e < 8; ++e) s += (float)v[e] * (float)v[e]; }
      const float w = (float)(_Float16)WI[qrow * 8 + h], cw = fabsf(w) * sqrtf(s) * kmax; float plus = w > 0.f ? cw : 0.f, minus = w < 0.f ? cw : 0.f;
#pragma unroll
      for (int o = 1; o < 8; o <<= 1) { plus += __shfl_xor(plus, o); minus += __shfl_xor(minus, o); }
      if (h == 0) { const float width = (plus + minus) * 1.02f + 1e-20f; const float rinv_ = fminf((float)NBIN / width, 60000.f); const _Float16 rvh = (_Float16)rinv_;
          RLO[wid * 8 + qw] = fminf(fmaxf(1024.f + minus * 1.02f * (float)rvh, 1024.f), 1535.f); RINV[wid * 8 + qw] = (float)rvh; } }
    f16x8 af[2][4], wa[4];
#pragma unroll
    for (int T = 0; T < 2; ++T) { const size_t qrow = rowbase + q0 + wid * 8 + 4 * T + (n32 >> 3);
#pragma unroll
        for (int ks = 0; ks < 4; ++ks) af[T][ks] = *(const f16x8*)(QIh + qrow * 512 + (n32 & 7) * 64 + 16 * ks + 8 * hi); }
    { const int m = n32; const f32x4 wv = (m < 8) ? *(const f32x4*)(WI + (rowbase + q0 + wid * 8 + m) * 8 + 4 * hi) : (f32x4){0.f, 0.f, 0.f, 0.f};
#pragma unroll
      for (int s = 0; s < 4; ++s) { f16x8 w8;
#pragma unroll
          for (int j = 0; j < 8; ++j) w8[j] = (_Float16)((m == 2 * s + (j >> 2)) ? wv[j & 3] : 0.f);
          wa[s] = w8; } }
    __syncthreads();
    f16x2 rv[2], nl[2];
#pragma unroll
    for (int p = 0; p < 2; ++p) { rv[p] = (f16x2){(_Float16)RINV[wid * 8 + 4 * hi + 2 * p], (_Float16)RINV[wid * 8 + 4 * hi + 2 * p + 1]}; nl[p] = (f16x2){(_Float16)RLO[wid * 8 + 4 * hi + 2 * p], (_Float16)RLO[wid * 8 + 4 * hi + 2 * p + 1]}; }
    unsigned long long* SCw = SCblk + wid * 64 + lane;
    idx_tiles<0>(c, NT, SCw, KIh, af, wa, rv, nl);
#ifdef PROBE_P0MODE
    idx_tiles<0, PROBE_P0MODE>(c, NT, SCw, KIh, af, wa, rv, nl);
#endif
    asm volatile("s_waitcnt vmcnt(0)" ::: "memory");
    idx_boundary(c);
    __syncthreads();
    { LAS u32x4* z = (LAS u32x4*)((LAS unsigned*)(c.lds + X_CAND) + wid * 8 * CAP);
#pragma unroll
      for (int j = 0; j < 3; ++j) z[lane + 64 * j] = (u32x4){0u, 0u, 0u, 0u}; }
    unsigned thi[8], tlo[8];
    { const int rr = (lane >> 1) & 7, rowl = wid * 8 + rr; const _Float16 nl_ = (_Float16)RLO[rowl], rv_ = (_Float16)RINV[rowl]; const int target = RBST[rowl] - (lane & 1);
      int lo = 0x03FF, hi_ = 0xFC00;
#pragma unroll 1
      for (int it = 0; it < 16; ++it) { const int mid = (lo + hi_) >> 1; const unsigned hbm = (mid & 0x8000) ? (unsigned)(mid ^ 0x8000) : (~(unsigned)mid & 0xFFFFu);
          const bool up = idx_bin(hbm, rv_, nl_) > target; hi_ = up ? mid : hi_; lo = up ? lo : mid; }
      const unsigned T = (hi_ & 0x8000) ? (unsigned)(hi_ ^ 0x8000) : (~(unsigned)hi_ & 0xFFFFu);
#pragma unroll
      for (int r = 0; r < 8; ++r) { thi[r] = __builtin_amdgcn_readlane(T, 2 * r); tlo[r] = __builtin_amdgcn_readlane(T, 2 * r + 1); } }
    idx_emit(c, NT, SCblk, thi, tlo);
#ifdef PROBE_EMIT2
    idx_emit(c, NT, SCblk, thi, tlo);
#endif
    asm volatile("s_waitcnt lgkmcnt(0)" ::: "memory");
    {
        LAS unsigned short* LIST = (LAS unsigned short*)(c.lds + X_BM); LAS int* CABV = (LAS int*)(c.lds + X_RED) + 128;
        const int r = lane >> 3, g = lane & 7, rowl = wid * 8 + r;
        int nc = CCNT[rowl]; nc = nc > CAP ? CAP : nc; const int need = RNEED[rowl], na = CABV[rowl];
        int ncmax = nc;
#pragma unroll
        for (int o = 8; o < 64; o <<= 1) ncmax = max(ncmax, __shfl_xor(ncmax, o));
        ncmax = __builtin_amdgcn_readfirstlane(ncmax);
        const LAS unsigned* cs = (const LAS unsigned*)(c.lds + X_CAND) + rowl * CAP;
#pragma unroll 1
        for (int i0 = 0; i0 < ncmax; i0 += 8) { const int i = i0 + g; const bool have = i < nc; const unsigned ci = cs[i]; int rank = 0;
#pragma unroll 1
            for (int k0 = 0; k0 < ncmax; k0 += 8) { const u32x4 ka = *(const LAS u32x4*)(cs + k0), kb = *(const LAS u32x4*)(cs + k0 + 4);
                rank += (int)(ka.x > ci) + (int)(ka.y > ci) + (int)(ka.z > ci) + (int)(ka.w > ci) + (int)(kb.x > ci) + (int)(kb.y > ci) + (int)(kb.z > ci) + (int)(kb.w > ci); }
            const int p = na + rank;
            if (have && rank < need && p < 256) LIST[rowl * 256 + p] = (unsigned short)(0xFFFFu - (ci & 0xFFFFu)); }
        asm volatile("s_waitcnt lgkmcnt(0)" ::: "memory");
        const LAS u32x4* src = (const LAS u32x4*)(LIST + wid * 8 * 256) + lane * 4; u32x4* dst = (u32x4*)(SEL + (rowbase + q0 + wid * 8) * 256) + lane * 4;
#pragma unroll
        for (int k = 0; k < 4; ++k) dst[k] = src[k];
    }
    asm volatile("s_waitcnt vmcnt(0) lgkmcnt(0)\n\ts_barrier" ::: "memory");
}

typedef short s16x4v __attribute__((ext_vector_type(4)));
constexpr int A_BUF = 0, A_SEL = 65536, A_BKB = 65536 + 4096, A_BKT = 65536 + 8192, A_RB = A_BKT + 8192, A_END = A_RB + 2048 + 64;
__device__ __forceinline__ void dsa_tables(const Ctx& c, const float* relb) {
    LAS unsigned char* BK = c.lds + A_BKT; LAS float* RB = (LAS float*)(c.lds + A_RB);
    for (int i = c.tid; i < 8192; i += 512) BK[i] = (unsigned char)(int)att::t5_bucket_f(i);
    RB[c.tid] = relb[c.tid] * LOG2E; if (c.tid < 16) RB[512 + c.tid] = -INFINITY;
    __syncthreads();
}
__device__ __forceinline__ int swz(int row) { return 2 * (row & 7) + ((row >> 3) & 1); }
__device__ __forceinline__ void dsa_query(const Ctx& c, int tok, const unsigned char* QPU, unsigned char* UO, const unsigned char* CKVN, const unsigned short* SEL) {
    int lane = c.lane; asm volatile("" : "+v"(lane));
    const int wid = c.wave, l15 = lane & 15, kq = lane >> 4;
    const int b = tok / SEQ, q = tok - b * SEQ; const size_t rowbase = (size_t)b * SEQ;
    const int nsel = (q + 1 < 256) ? q + 1 : 256, nch = (nsel + 15) >> 4;
    const unsigned lds0 = (unsigned)(size_t)c.lds;
    LAS unsigned char* buf = c.lds + A_BUF + wid * 8192; const unsigned buf0 = lds0 + A_BUF + wid * 8192;
    LAS unsigned short* lsel = (LAS unsigned short*)(c.lds + A_SEL + wid * 512);
    LAS unsigned char* lbk = c.lds + A_BKB + wid * 256;
    const LAS unsigned char* BK = c.lds + A_BKT; const LAS float* RB = (const LAS float*)(c.lds + A_RB);
    asm volatile("s_waitcnt lgkmcnt(0)" ::: "memory");
    { const u32x2 v = __builtin_nontemporal_load((const u32x2*)(SEL + (size_t)tok * 256) + lane); *((LAS u32x2*)lsel + lane) = v;
      unsigned bw = 0;
#pragma unroll
      for (int i = 0; i < 4; ++i) { const int e = 4 * lane + i; const int key = (int)(((i < 2) ? v.x : v.y) >> (16 * (i & 1))) & 0xffff; const int dist = q - key; const unsigned bk = (e < nsel && dist >= 0) ? (unsigned)BK[dist] : 32u; bw |= bk << (8 * i); }
      *((LAS unsigned*)lbk + lane) = bw; }
    bf16x8 qf[8];
#pragma unroll
    for (int ks = 0; ks < 8; ++ks) { const u32x2 w = __builtin_nontemporal_load((const u32x2*)(QPU + (size_t)tok * 4096 + l15 * 256 + 64 * (ks >> 1) + 16 * kq + 8 * (ks & 1)));
        const f32x2 a0 = __builtin_amdgcn_cvt_pk_f32_fp8((int)w.x, false), a1 = __builtin_amdgcn_cvt_pk_f32_fp8((int)w.x, true), a2 = __builtin_amdgcn_cvt_pk_f32_fp8((int)w.y, false), a3 = __builtin_amdgcn_cvt_pk_f32_fp8((int)w.y, true);
        u32x4 q4; q4.x = att::cvtpk(a0.x, a0.y); q4.y = att::cvtpk(a1.x, a1.y); q4.z = att::cvtpk(a2.x, a2.y); q4.w = att::cvtpk(a3.x, a3.y); qf[ks] = __builtin_bit_cast(bf16x8, q4); }
    asm volatile("s_waitcnt lgkmcnt(0)" ::: "memory");
#define DSA_SELROW(ch) ({ int e_ = 16 * (ch) + l15; e_ = e_ < nsel ? e_ : 0; (unsigned)lsel[e_]; })
#define DSA_LOADROW(R, row) do { const unsigned char* rp_ = CKVN + (rowbase + (row)) * 256 + 16 * kq; \
        _Pragma("unroll") for (int ksp = 0; ksp < 4; ++ksp) R[ksp] = *(const u32x4*)(rp_ + 64 * ksp); } while (0)
#define DSA_LOAD(R, ch) DSA_LOADROW(R, DSA_SELROW(ch))
    typedef __bf16 bf2_t __attribute__((ext_vector_type(2)));
#define DSA_CVT(w_, sel_) __builtin_bit_cast(unsigned, __builtin_amdgcn_cvt_scalef32_pk_bf16_fp8((int)(w_), 1.0f, sel_))
    u32x4 R0[4], R1[4], R2[4];
    DSA_LOAD(R0, 0); DSA_LOAD(R1, 1); DSA_LOAD(R2, 2);
    unsigned seln = DSA_SELROW(3), bwn = *((const LAS unsigned*)lbk + kq);
    float m_run = -INFINITY, l_run = 0.f;
    f32x4 o[16];
#pragma unroll
    for (int ct = 0; ct < 16; ++ct) o[ct] = (f32x4){0.f, 0.f, 0.f, 0.f};
    const int wrow = l15 * 512, wsw = swz(l15);
    const int trow = 4 * kq + ((lane & 15) >> 2), tsw = swz(trow);
    const int tbase = (int)buf0 + trow * 512 + (lane & 1) * 8;
#define DSA_CHUNK(R, ch, LOADC) do { f32x4 s; float rbv[4]; \
        { const unsigned bw = bwn; if ((ch) + 1 < 16) bwn = *((const LAS unsigned*)lbk + 4 * ((ch) + 1) + kq);              \
          _Pragma("unroll") for (int i = 0; i < 4; ++i) rbv[i] = RB[((bw >> (8 * i)) & 0xffu) * 16 + l15]; } \
        __builtin_amdgcn_sched_barrier(0); { \
        bf16x8 a_[8]; \
        _Pragma("unroll") for (int ksp = 0; ksp < 4; ++ksp) { const u32x4 r_ = R[ksp]; \
            a_[2 * ksp] = __builtin_bit_cast(bf16x8, (u32x4){DSA_CVT(r_.x, false), DSA_CVT(r_.x, true), DSA_CVT(r_.y, false), DSA_CVT(r_.y, true)}); \
            a_[2 * ksp + 1] = __builtin_bit_cast(bf16x8, (u32x4){DSA_CVT(r_.z, false), DSA_CVT(r_.z, true), DSA_CVT(r_.w, false), DSA_CVT(r_.w, true)}); } \
        __builtin_amdgcn_sched_barrier(0); if (LOADC) { DSA_LOADROW(R, seln); if ((ch) + 4 < 16) seln = DSA_SELROW((ch) + 4); }            \
        f32x4 s0 = (f32x4){0.f, 0.f, 0.f, 0.f}, s1 = (f32x4){0.f, 0.f, 0.f, 0.f}; \
        _Pragma("unroll") for (int ks = 0; ks < 8; ks += 2) { s0 = __builtin_amdgcn_mfma_f32_16x16x32_bf16(a_[ks], qf[ks], s0, 0, 0, 0); s1 = __builtin_amdgcn_mfma_f32_16x16x32_bf16(a_[ks + 1], qf[ks + 1], s1, 0, 0, 0); } \
        _Pragma("unroll") for (int ks = 0; ks < 8; ++ks) *(LAS bf16x8*)(buf + wrow + ((((8 * (ks >> 1) + 2 * kq + (ks & 1))) ^ wsw) * 16)) = a_[ks]; \
        s = (s0 + s1) * (1.0f / (FP8_SQ * FP8_SCK)); } \
        float mx = -INFINITY; \
        _Pragma("unroll") for (int i = 0; i < 4; ++i) { s[i] += rbv[i]; mx = fmaxf(mx, s[i]); } \
        { auto r16_ = __builtin_amdgcn_permlane16_swap(__float_as_uint(mx), __float_as_uint(mx), false, false); mx = fmaxf(__uint_as_float(r16_[0]), __uint_as_float(r16_[1])); } mx = att::half_swap_max(mx);            \
        const float mnew = (mx > m_run + 8.0f) ? mx : m_run, alpha = __builtin_amdgcn_exp2f(m_run - mnew);            \
        m_run = mnew; \
        float p[4]; \
        _Pragma("unroll") for (int i = 0; i < 4; ++i) p[i] = __builtin_amdgcn_exp2f(s[i] - mnew); \
        l_run = l_run * alpha + (p[0] + p[1]) + (p[2] + p[3]); \
        if (__any(alpha != 1.0f)) {            \
            float a4[4]; \
            _Pragma("unroll") for (int i = 0; i < 4; ++i) a4[i] = __shfl(alpha, 4 * kq + i); \
            _Pragma("unroll") for (int ct = 0; ct < 16; ++ct) { o[ct][0] *= a4[0]; o[ct][1] *= a4[1]; o[ct][2] *= a4[2]; o[ct][3] *= a4[3]; } \
        } \
        u32x2 pw; pw.x = att::cvtpk(p[0], p[1]); pw.y = att::cvtpk(p[2], p[3]); \
        const s16x4v pa = __builtin_bit_cast(s16x4v, pw); \
          \
        _Pragma("unroll") for (int c8 = 0; c8 < 2; ++c8) { s16x4v bv[8]; \
            _Pragma("unroll") for (int u = 0; u < 8; ++u) { const int ct = 8 * c8 + u; const int addr = tbase + ((((2 * ct + ((lane & 3) >> 1))) ^ tsw) * 16); asm volatile("ds_read_b64_tr_b16 %0,%1" : "=v"(bv[u]) : "v"(addr) : "memory"); } \
            asm volatile("s_waitcnt lgkmcnt(0)" ::: "memory"); __builtin_amdgcn_sched_barrier(0); \
            _Pragma("unroll") for (int u = 0; u < 8; ++u) o[8 * c8 + u] = __builtin_amdgcn_mfma_f32_16x16x16bf16_1k(pa, bv[u], o[8 * c8 + u], 0, 0, 0); } \
    } while (0)
#pragma unroll 1
    for (int ch = 0; ch < 12; ch += 3) { DSA_CHUNK(R0, ch, true); DSA_CHUNK(R1, ch + 1, true); DSA_CHUNK(R2, ch + 2, true); }
    DSA_CHUNK(R0, 12, true); DSA_CHUNK(R1, 13, false); DSA_CHUNK(R2, 14, false); DSA_CHUNK(R0, 15, false);
#undef DSA_LOAD
#undef DSA_LOADROW
#undef DSA_SELROW
#undef DSA_CHUNK
#undef DSA_CVT
    float lt = l_run; lt += __shfl_xor(lt, 16); lt += __shfl_xor(lt, 32);
    const float rl = 1.0f / lt; float r4[4];
#pragma unroll
    for (int i = 0; i < 4; ++i) r4[i] = __shfl(rl, 4 * kq + i);
    LAS unsigned char* stg = buf;
    asm volatile("s_waitcnt lgkmcnt(0)" ::: "memory");
#pragma unroll
    for (int ct = 0; ct < 16; ++ct)
#pragma unroll
        for (int i = 0; i < 4; ++i) stg[(4 * kq + i) * 256 + 16 * ct + l15] = to_fp8(o[ct][i] * (r4[i] * (FP8_SU / FP8_SCK)));
    asm volatile("s_waitcnt lgkmcnt(0)" ::: "memory");
#pragma unroll
    for (int i = 0; i < 4; ++i) { const u32x4 v = *((const LAS u32x4*)stg + i * 64 + lane); __builtin_nontemporal_store(v, (u32x4*)(UO + (size_t)tok * 4096) + i * 64 + lane); }
    asm volatile("s_waitcnt lgkmcnt(0)" ::: "memory");
}
}
#ifndef ONE_LAUNCH
#define ONE_LAUNCH 0
#endif
constexpr int NPHASE = 17;
typedef const __attribute__((address_space(4))) Args* KArgPtr;
#if defined(__HIP_DEVICE_COMPILE__)
#define PHASE_ARGS_LOAD(a) KArgPtr ap_ = (KArgPtr)__builtin_amdgcn_kernarg_segment_ptr(); asm volatile("" : "+s"(ap_)); const Args a = *ap_
#else
#define PHASE_ARGS_LOAD(a) const Args a = a0
#endif
#define PHASE_ARGS(a) PHASE_ARGS_LOAD(a); Ctx c = c0; { int l_ = (int)__builtin_amdgcn_mbcnt_hi(~0u, __builtin_amdgcn_mbcnt_lo(~0u, 0u)); asm volatile("" : "+v"(l_)); c.lane = l_; c.tid = c0.wave * 64 + l_; } \
    unsigned* const ctl = (unsigned*)(a.ws + WS_CTL); float* const X = a.out; const float* const MODS0 = (const float*)(a.ws + WS_MODS); const float* const MODS1 = MODS0 + 4 * 6144; bf16_t* const Hb = (bf16_t*)(a.ws + WS_H); bf16_t* const X16 = (bf16_t*)(a.ws + WS_X16); \
    (void)ctl; (void)X; (void)MODS0; (void)MODS1; (void)Hb; (void)X16
__global__ void __launch_bounds__(512, 2) mk_fwd(Args a0) {
    extern __shared__ __attribute__((aligned(16))) unsigned char lds_[];
    Ctx c0; c0.lds = (LAS unsigned char*)lds_; c0.tid = threadIdx.x; c0.lane = c0.tid & 63; c0.wave = __builtin_amdgcn_readfirstlane(c0.tid >> 6);
    c0.G = gridDim.x; { const int bx = blockIdx.x; c0.vcu = (c0.G % 8 == 0) ? (bx % 8) * (c0.G / 8) + bx / 8 : bx; }
    volatile LAS unsigned* MISC = (volatile LAS unsigned*)(c0.lds + MISC_OFF);
    if (c0.tid < 64) MISC[c0.tid] = 0u;
    __syncthreads();
    XcdBarrier bar; bar.bar = (unsigned*)(a0.ws + WS_CTL) + CW_BAR; bar.x = 0; bar.st = MISC + 8;
    if (a0.ph_hi - a0.ph_lo > 1) bar = xcd_barrier_post(bar.bar, MISC + 8, c0.tid == 0);
    const int lo = a0.ph_lo, hi = a0.ph_hi;
#if defined(PH_ONLY)
#define IN(k) ((k) == PH_ONLY)
#elif defined(PH_MASK)
#define IN(k) (((PH_MASK >> (k)) & 1) && lo <= (k) && (k) < hi)
#else
#define IN(k) (lo <= (k) && (k) < hi)
#endif
#ifndef REP_MASK
#define REP_MASK 0
#endif
#define PH(k) if (IN(k))
#define SEAM(k) do { if (IN(k) && IN((k) + 1)) xcd_barrier(bar, c0.wave == 0 && __builtin_amdgcn_mbcnt_hi(~0u, __builtin_amdgcn_mbcnt_lo(~0u, 0u)) == 0u); } while (0)

#ifdef CALIB_A
    { PHASE_ARGS(a); if (lo == 0) { ThinArgs t{}; t.src = a.in[I_X]; t.nw = a.in[I_FN]; t.fdst = a.out; thin_pass<false, 0, false, true, false>(c, a, t); } return; }
#endif
    PH(0) { PHASE_ARGS(a); p0_prologue(c, a); }
#if (REP_MASK >> 0) & 1
    __syncthreads();
    PH(0) { PHASE_ARGS(a); p0_prologue(c, a); }
#endif
    SEAM(0);
    PH(1) {
        PHASE_ARGS(a); ThinArgs t{}; t.src = a.in[I_X]; t.xdst = X; t.nw = a.in[I_L0N1]; t.mods = MODS0; t.sh_off = 0; t.hdst = Hb; t.w8 = a.in[I_L0WIN] + 1536; t.w8ld = EVEN_IN; t.fb = a.in[I_L0FB]; t.e8dst = (float*)(a.ws + WS_LF);
        thin_pass<false, 1, false, false, false>(c, a, t);
    }
    SEAM(1);
    PH(2) {
        PHASE_ARGS(a);
        if (blockIdx.x < 32) att::fox_scan(c, (const float*)(a.ws + WS_LF), (float*)(a.ws + WS_KB2), blockIdx.x);
        DenseSched S{(const char*)(a.ws + WS_BT0), DM / 2, 15, 128 * 15, c.G, c.vcu}; EpiBf16Plain E{(bf16_t*)(a.ws + WS_QKV0), QKV0_LD, 1.0f / (FP8_SH * FP8_SW0)};
        pg8::gemm_phase<EpiBf16Plain, DenseSched, true, true>(c.lds, c.tid, Hb, DM, DM, S, E);
    }
#if (REP_MASK >> 2) & 1
    __syncthreads();
    PH(2) {
        PHASE_ARGS(a);
        if (blockIdx.x < 32) att::fox_scan(c, (const float*)(a.ws + WS_LF), (float*)(a.ws + WS_KB2), blockIdx.x);
        DenseSched S{(const char*)(a.ws + WS_BT0), DM / 2, 15, 128 * 15, c.G, c.vcu}; EpiBf16Plain E{(bf16_t*)(a.ws + WS_QKV0), QKV0_LD, 1.0f / (FP8_SH * FP8_SW0)};
        pg8::gemm_phase<EpiBf16Plain, DenseSched, true, true>(c.lds, c.tid, Hb, DM, DM, S, E);
    }
#endif
    SEAM(2);
    PH(3) {
        PHASE_ARGS(a);
        const bf16_t* QKV = (const bf16_t*)(a.ws + WS_QKV0); bf16_t* MER = (bf16_t*)(a.ws + WS_MER);
        for (int v = c.vcu; v < 256; v += c.G) { const int bh = v >> 3, s = v & 7;
            float kmaxn;
            { const bf16_t* Kh = QKV + (size_t)(bh >> 3) * SEQ * QKV0_LD + 512 + (bh & 7) * 64; float m2 = 0.f;
#pragma unroll 1
              for (int k = c.tid; k < SEQ; k += 512) { const u32x4* kp = (const u32x4*)(Kh + (size_t)k * QKV0_LD); float s2 = 0.f;
#pragma unroll
                  for (int i = 0; i < 8; ++i) { const u32x4 w_ = kp[i];
#pragma unroll
                      for (int e = 0; e < 4; ++e) { const float lo_ = __builtin_bit_cast(float, w_[e] << 16), hi_ = __builtin_bit_cast(float, w_[e] & 0xffff0000u); s2 += lo_ * lo_ + hi_ * hi_; } }
                  m2 = fmaxf(m2, s2); }
#pragma unroll
              for (int o_ = 1; o_ < 64; o_ <<= 1) m2 = fmaxf(m2, __shfl_xor(m2, o_));
              LAS float* km = (LAS float*)(c.lds + att::F_WS + 2048 + 64);
              if (c.lane == 0) km[c.wave] = m2;
              __syncthreads();
              m2 = km[0];
#pragma unroll
              for (int w_ = 1; w_ < 8; ++w_) m2 = fmaxf(m2, km[w_]);
              kmaxn = sqrtf(m2); __syncthreads(); }
#pragma unroll 1
            for (int i = 0; i < 4; ++i) { const int qb = (i == 0) ? s : (i == 1) ? 15 - s : (i == 2) ? 16 + s : 31 - s; att::fox_unit(c, bh >> 3, bh & 7, qb, QKV, (const float*)(a.ws + WS_KB2), MER, kmaxn); } }
#ifdef PROBE_FOX2
        for (int v = c.vcu; v < 256; v += c.G) { const int bh = v >> 3, s = v & 7;
#pragma unroll 1
            for (int i = 0; i < 4; ++i) { const int qb = (i == 0) ? s : (i == 1) ? 15 - s : (i == 2) ? 16 + s : 31 - s; att::fox_unit(c, bh >> 3, bh & 7, qb, QKV, (const float*)(a.ws + WS_KB2), MER, 1e30f); } }
#endif
        att::dil_tables(c, a.in[I_RELB]);
        { unsigned* dq = ctl + 8192;
#pragma unroll 1
          for (;;) { unsigned u = 0; if (c.lane == 0) u = __hip_atomic_fetch_add(dq, 1u, __ATOMIC_RELAXED, __HIP_MEMORY_SCOPE_AGENT); u = __builtin_amdgcn_readfirstlane(u); if (u >= 4096u) break;
            att::dil_unit(c, (int)u, QKV, MER);
#ifdef CONV_IN_P3
            asm volatile("s_waitcnt vmcnt(0) lgkmcnt(0)" ::: "memory");
#pragma unroll 1
            for (int k = 0; k < 12; ++k) { int ln_ = c.lane; asm volatile("" : "+v"(ln_)); convert_moe_item(12 * (int)u + k, ln_, a.in[I_L0W1], a.in[I_L0W2], a.ws + WS_W1T, a.ws + WS_W2T, (LAS float*)(c.lds + att::D_TILE + c.wave * 16384)); }
#endif
          } }
#ifdef PROBE_DIL2
        __syncthreads();
#pragma unroll 1
        for (int u = c.vcu * 8 + c.wave; u < 4096; u += c.G * 8) att::dil_unit(c, u, QKV, MER);
#endif
    }
#if (REP_MASK >> 3) & 1
    __syncthreads();
    PH(3) {
        PHASE_ARGS(a);
        const bf16_t* QKV = (const bf16_t*)(a.ws + WS_QKV0); bf16_t* MER = (bf16_t*)(a.ws + WS_MER);
        for (int v = c.vcu; v < 256; v += c.G) { const int bh = v >> 3, s = v & 7;
#pragma unroll 1
            for (int i = 0; i < 4; ++i) { const int qb = (i == 0) ? s : (i == 1) ? 15 - s : (i == 2) ? 16 + s : 31 - s; att::fox_unit(c, bh >> 3, bh & 7, qb, QKV, (const float*)(a.ws + WS_KB2), MER, 1e30f); } }
        att::dil_tables(c, a.in[I_RELB]);
#pragma unroll 1
        for (int u = c.vcu * 8 + c.wave; u < 4096; u += c.G * 8) att::dil_unit(c, u, QKV, MER);
    }
#endif
    SEAM(3);
    PH(4) {
        PHASE_ARGS(a); DenseSched S{(const char*)(a.ws + WS_WO0), MER_LD, 4, 128 * 4, c.G, c.vcu}; EpiResid<false, true> E{a.in[I_X], X16, MODS0 + 2048, 1.0f};
        pg8::gemm_phase<EpiResid<false, true>, DenseSched, true>(c.lds, c.tid, (const bf16_t*)(a.ws + WS_MER), MER_LD, MER_LD, S, E);
    }
#if (REP_MASK >> 4) & 1
    __syncthreads();
    PH(4) {
        PHASE_ARGS(a); DenseSched S{(const char*)(a.ws + WS_WO0), MER_LD, 4, 128 * 4, c.G, c.vcu}; EpiResid<false, true> E{a.in[I_X], X16, MODS0 + 2048, 1.0f};
        pg8::gemm_phase<EpiResid<false, true>, DenseSched, true>(c.lds, c.tid, (const bf16_t*)(a.ws + WS_MER), MER_LD, MER_LD, S, E);
    }
#endif
    SEAM(4);
#define ROUTER_PHASE(P, L, NW, RWI, RBI, MODS) PH(P) { PHASE_ARGS(a); ThinArgs t{}; t.src = (const float*)X16; t.nw = a.in[NW]; t.mods = MODS; t.sh_off = 3072; t.hdst = Hb; t.rw = a.in[RWI]; t.rb = a.in[RBI]; t.layer = L; \
        thin_pass<false, 0, true, false, false, true, false>(c, a, t); }
#define MOE1_PHASE(P, L, B1I) PH(P) { PHASE_ARGS(a); moe_tables(c, ctl, L); MoeSched<8, true> S{(const LAS int*)(c.lds + MOE_TS), (const LAS int*)(c.lds + MOE_TS) + 64, (const int*)(a.ws + WS_TOK), (const char*)(a.ws + WS_W1T), c.G, c.vcu, __builtin_amdgcn_readfirstlane(((const LAS int*)(c.lds + MOE_TS))[32])}; \
        EpiSwiglu E{a.ws + WS_ACT, a.in[B1I]}; pg8::gemm_phase<EpiSwiglu, MoeSched<8, true>, true, true>(c.lds, c.tid, Hb, DM, DM, S, E); }
#define MOE2_PHASE(P, L, B2I) PH(P) { PHASE_ARGS(a); moe_tables(c, ctl, L); MoeSched<4, false> S{(const LAS int*)(c.lds + MOE_TS), (const LAS int*)(c.lds + MOE_TS) + 64, nullptr, (const char*)(a.ws + WS_W2T), c.G, c.vcu, __builtin_amdgcn_readfirstlane(((const LAS int*)(c.lds + MOE_TS))[32])}; \
        EpiBiasBf16 E{a.ws + WS_Y, a.in[B2I]}; pg8::gemm_phase<EpiBiasBf16, MoeSched<4, false>, true, true>(c.lds, c.tid, (const bf16_t*)(a.ws + WS_ACT), DEXP, DEXP, S, E); }
    ROUTER_PHASE(5, 0, I_L0N2, I_L0RW, I_L0RB, MODS0)
    SEAM(5);
    MOE1_PHASE(6, 0, I_L0B1)
#if (REP_MASK >> 6) & 1
    __syncthreads();
    MOE1_PHASE(6, 0, I_L0B1)
#endif
    SEAM(6);
    MOE2_PHASE(7, 0, I_L0B2)
#ifdef PROBE_P7NOEPI
    __syncthreads();
    PH(7) { PHASE_ARGS(a); moe_tables(c, ctl, 0); MoeSched<4, false> S{(const LAS int*)(c.lds + MOE_TS), (const LAS int*)(c.lds + MOE_TS) + 64, nullptr, (const char*)(a.ws + WS_W2T), c.G, c.vcu, __builtin_amdgcn_readfirstlane(((const LAS int*)(c.lds + MOE_TS))[32])};
        EpiNone E{}; pg8::gemm_phase<EpiNone, MoeSched<4, false>, true, true>(c.lds, c.tid, (const bf16_t*)(a.ws + WS_ACT), DEXP, DEXP, S, E); }
#endif
#if (REP_MASK >> 7) & 1
    __syncthreads();
    MOE2_PHASE(7, 0, I_L0B2)
#endif
    SEAM(7);
#ifdef PROBE_T8
    PH(8) { PHASE_ARGS(a); ThinArgs t{}; t.src = X; t.xdst = (float*)(a.ws + WS_R1 + 136 * MiB); t.nw = a.in[I_L1N1]; t.mods = MODS1; t.sh_off = 0; t.cmods = MODS0; t.hdst = (bf16_t*)(a.ws + 96 * MiB); t.w8 = a.in[I_L1WIN] + 1856; t.w8ld = ODD_IN; t.e8dst = (float*)(a.ws + 191 * MiB); t.h8dst = a.ws + 192 * MiB; t.layer = 0; t.Y = a.ws + WS_Y;
        thin_pass<true, 2, false, false, false>(c, a, t); __syncthreads(); }
#endif
    PH(8) {
        PHASE_ARGS(a); ThinArgs t{}; t.src = (const float*)X16; t.xdst = (float*)X16; t.nw = a.in[I_L1N1]; t.mods = MODS1; t.sh_off = 0; t.cmods = MODS0; t.hdst = Hb; t.w8 = a.in[I_L1WIN] + 1856; t.w8ld = ODD_IN; t.e8dst = (float*)(a.ws + WS_WI); t.h8dst = a.ws + WS_H8; t.layer = 0; t.Y = a.ws + WS_Y;
        thin_pass<true, 2, false, false, false, true, true>(c, a, t);
        __syncthreads();
#ifndef CONV_IN_P11
        convert_moe_weights(c, a.in[I_L1W1], a.in[I_L1W2], a.ws + WS_W1T, a.ws + WS_W2T, (LAS float*)(c.lds + c.wave * 8704));
#endif
#ifdef PROBE_CONV2
        convert_moe_weights(c, a.in[I_L1W1], a.in[I_L1W2], a.ws + WS_W1T, a.ws + WS_W2T, (LAS float*)(c.lds + c.wave * 8704));
#endif
    }
    SEAM(8);
    PH(9) {
        PHASE_ARGS(a);
        { DenseSched S{(const char*)(a.ws + WS_BT1), DM / 2, 16, 128 * 16, c.G, c.vcu}; EpiFp8Plain E{a.ws + WS_QP, 4096, FP8_SQ / (FP8_SH * FP8_SQP)};
          pg8::gemm_phase<EpiFp8Plain, DenseSched, true, true>(c.lds, c.tid, (const bf16_t*)(a.ws + WS_H8), DM, DM, S, E); }
        { DenseSched S{(const char*)(a.ws + WS_BT1) + (size_t)4096 * 1024 * 2, DM, 4, 128 * 4, c.G, c.vcu};
          EpiL1Proj E{(bf16_t*)(a.ws + WS_QP), (bf16_t*)(a.ws + WS_CKV), (bf16_t*)(a.ws + WS_QI), (bf16_t*)(a.ws + WS_KI)};
          pg8::gemm_phase<EpiL1Proj, DenseSched, true>(c.lds, c.tid, Hb, DM, DM, S, E); }
    }
#if (REP_MASK >> 9) & 1
    __syncthreads();
    PH(9) {
        PHASE_ARGS(a);
        { DenseSched S{(const char*)(a.ws + WS_BT1), DM / 2, 16, 128 * 16, c.G, c.vcu}; EpiFp8Plain E{a.ws + WS_QP, 4096, FP8_SQ / (FP8_SH * FP8_SQP)};
          pg8::gemm_phase<EpiFp8Plain, DenseSched, true, true>(c.lds, c.tid, (const bf16_t*)(a.ws + WS_H8), DM, DM, S, E); }
        { DenseSched S{(const char*)(a.ws + WS_BT1) + (size_t)4096 * 1024 * 2, DM, 4, 128 * 4, c.G, c.vcu};
          EpiL1Proj E{(bf16_t*)(a.ws + WS_QP), (bf16_t*)(a.ws + WS_CKV), (bf16_t*)(a.ws + WS_QI), (bf16_t*)(a.ws + WS_KI)};
          pg8::gemm_phase<EpiL1Proj, DenseSched, true>(c.lds, c.tid, Hb, DM, DM, S, E); }
    }
#endif
    SEAM(9);
    PH(10) {
        PHASE_ARGS(a);
        dsa::ckv_norm(c, (const bf16_t*)(a.ws + WS_CKV), a.in[I_L1KVN], a.ws + WS_CKVN);
        for (int v = c.vcu; v < 256; v += c.G) { const int b = v >> 6, p = v & 63;
#pragma unroll 1
            for (int u = 0; u < 2; ++u) dsa::idx_unit(c, b, u ? 127 - p : p, (const bf16_t*)(a.ws + WS_QI), (const bf16_t*)(a.ws + WS_KI), (const float*)(a.ws + WS_WI), (unsigned short*)(a.ws + WS_SEL),
                (unsigned long long*)(a.ws + (blockIdx.x < 128 ? WS_R1 + 128 * MiB : WS_R1 + 468 * MiB) + (size_t)(blockIdx.x & 127) * MiB)); }
    }
#if (REP_MASK >> 10) & 1
    __syncthreads();
    PH(10) {
        PHASE_ARGS(a);
        dsa::ckv_norm(c, (const bf16_t*)(a.ws + WS_CKV), a.in[I_L1KVN], a.ws + WS_CKVN);
        for (int v = c.vcu; v < 256; v += c.G) { const int b = v >> 6, p = v & 63;
#pragma unroll 1
            for (int u = 0; u < 2; ++u) dsa::idx_unit(c, b, u ? 127 - p : p, (const bf16_t*)(a.ws + WS_QI), (const bf16_t*)(a.ws + WS_KI), (const float*)(a.ws + WS_WI), (unsigned short*)(a.ws + WS_SEL),
                (unsigned long long*)(a.ws + (blockIdx.x < 128 ? WS_R1 + 128 * MiB : WS_R1 + 468 * MiB) + (size_t)(blockIdx.x & 127) * MiB)); }
    }
#endif
    SEAM(10);
    PH(11) {
        PHASE_ARGS(a);
        dsa::dsa_tables(c, a.in[I_RELB]);
#ifdef CONV_IN_P11
        LAS float* cscr = (LAS float*)(c.lds + dsa::A_END + c.wave * 8704); int cit = c.vcu * 8 + c.wave; const int cstep = c.G * 8; int par = 0;
#endif
#pragma unroll 1
        for (int tok = c.vcu * 8 + c.wave; tok < NTOK; tok += c.G * 8) { dsa::dsa_query(c, tok, a.ws + WS_QP, a.ws + WS_U, a.ws + WS_CKVN, (const unsigned short*)(a.ws + WS_SEL));
#ifdef CONV_IN_P11
#pragma unroll 1
            for (int k = 0; k < 1 + par; ++k) { int ln_ = c.lane; asm volatile("" : "+v"(ln_)); if (cit < NEXP * (16 * 64 + 16 * 32)) convert_moe_item(cit, ln_, a.in[I_L1W1], a.in[I_L1W2], a.ws + WS_W1T, a.ws + WS_W2T, cscr); cit += cstep; }
            par ^= 1;
#endif
        }
#ifdef CONV_IN_P11
#pragma unroll 1
        for (; cit < NEXP * (16 * 64 + 16 * 32); cit += cstep) convert_moe_item(cit, c.lane, a.in[I_L1W1], a.in[I_L1W2], a.ws + WS_W1T, a.ws + WS_W2T, cscr);
#endif
    }
#if (REP_MASK >> 11) & 1
    __syncthreads();
    PH(11) {
        PHASE_ARGS(a);
        dsa::dsa_tables(c, a.in[I_RELB]);
#pragma unroll 1
        for (int tok = c.vcu * 8 + c.wave; tok < NTOK; tok += c.G * 8) dsa::dsa_query(c, tok, a.ws + WS_QP, a.ws + WS_U, a.ws + WS_CKVN, (const unsigned short*)(a.ws + WS_SEL));
    }
#endif
    SEAM(11);
#ifdef PROBE_P12
    PH(12) { PHASE_ARGS(a); DenseSched S{(const char*)(a.ws + WS_WC1), 4096 / 2, 4, 128 * 4, c.G, c.vcu}; EpiResid E{X, (float*)(a.ws + WS_R1), MODS1 + 2048, 1.0f / (FP8_SU * FP8_SWC)};
        pg8::gemm_phase<EpiResid, DenseSched, true, true>(c.lds, c.tid, (const bf16_t*)(a.ws + WS_U), 4096, 4096, S, E); __syncthreads(); }
#endif
    PH(12) {
        PHASE_ARGS(a); DenseSched S{(const char*)(a.ws + WS_WC1), 4096 / 2, 4, 128 * 4, c.G, c.vcu}; EpiResid<true, true> E{X16, X16, MODS1 + 2048, 1.0f / (FP8_SU * FP8_SWC)};
        pg8::gemm_phase<EpiResid<true, true>, DenseSched, true, true>(c.lds, c.tid, (const bf16_t*)(a.ws + WS_U), 4096, 4096, S, E);
    }
    SEAM(12);
#ifdef PROBE_T13
    PH(13) { PHASE_ARGS(a); ThinArgs t{}; t.src = X; t.nw = a.in[I_L1N2]; t.mods = MODS1; t.sh_off = 3072; t.hdst = (bf16_t*)(a.ws + WS_R1 + 64 * MiB); t.rw = a.in[I_L1RW]; t.rb = a.in[I_L1RB]; t.layer = 2; t.dbg_off = (size_t)(WS_R1 - WS_TOK);
        thin_pass<false, 0, true, false, false>(c, a, t); __syncthreads(); }
#endif
    ROUTER_PHASE(13, 1, I_L1N2, I_L1RW, I_L1RB, MODS1)
    SEAM(13);
    MOE1_PHASE(14, 1, I_L1B1)
#if (REP_MASK >> 14) & 1
    __syncthreads();
    MOE1_PHASE(14, 1, I_L1B1)
#endif
    SEAM(14);
    MOE2_PHASE(15, 1, I_L1B2)
#if (REP_MASK >> 15) & 1
    __syncthreads();
    MOE2_PHASE(15, 1, I_L1B2)
#endif
    SEAM(15);
#ifdef PROBE_T16
    PH(16) { PHASE_ARGS(a); ThinArgs t{}; t.src = X; t.xdst = (float*)(a.ws + WS_R1); t.nw = a.in[I_FN]; t.cmods = MODS1; t.fdst = (float*)(a.ws + WS_R1 + 128 * MiB); t.layer = 1; t.Y = a.ws + WS_Y;
        thin_pass<true, 0, false, true, false>(c, a, t); __syncthreads(); }
#endif
    PH(16) {
        PHASE_ARGS(a); ThinArgs t{}; t.src = (const float*)X16; t.nw = a.in[I_FN]; t.cmods = MODS1; t.fdst = a.out; t.layer = 1; t.Y = a.ws + WS_Y;
        thin_pass<true, 0, false, true, false, true, false>(c, a, t);
    }
#undef IN
#undef SEAM
}

extern "C" void kernel_launch(void* const* d_in, const int* in_sizes, int n_in, void* d_out, int out_size, void* d_ws, size_t ws_size, hipStream_t stream) {
    static int grid = 0;
    if (grid == 0) {
        if (n_in != 31 || out_size != NTOK * DM || ws_size < WS_END) { fprintf(stderr, "kernel_launch: unexpected shapes (n_in %d, out %d, ws %zu)\n", n_in, out_size, ws_size); grid = -1; return; }
        int dev = 0, cus = 0, per_cu = 0;
        if (hipGetDevice(&dev) != hipSuccess || hipDeviceGetAttribute(&cus, hipDeviceAttributeMultiprocessorCount, dev) != hipSuccess) { grid = -1; return; }
        if (hipFuncSetAttribute((const void*)mk_fwd, hipFuncAttributeMaxDynamicSharedMemorySize, LDS_BYTES) != hipSuccess) { fprintf(stderr, "kernel_launch: hipFuncSetAttribute failed\n"); grid = -1; return; }
        if (hipOccupancyMaxActiveBlocksPerMultiprocessor(&per_cu, (const void*)mk_fwd, 512, LDS_BYTES) != hipSuccess || per_cu < 1) { fprintf(stderr, "kernel_launch: occupancy query says %d\n", per_cu); }
        (void)hipGetLastError();
        grid = cus;
    }
    if (grid < 0) return;
    if (hipMemsetAsync((char*)d_ws + WS_CTL, 0, CTL_ZERO_BYTES, stream) != hipSuccess) return;
    Args a{};
    for (int i = 0; i < 31; ++i) a.in[i] = (const float*)d_in[i];
    a.out = (float*)d_out; a.ws = (unsigned char*)d_ws;
#if ONE_LAUNCH
    a.ph_lo = 0; a.ph_hi = NPHASE;
    hipLaunchKernelGGL(mk_fwd, dim3(grid), dim3(512), LDS_BYTES, stream, a);
#else
    for (int p = 0; p < NPHASE; ++p) { a.ph_lo = p; a.ph_hi = p + 1; hipLaunchKernelGGL(mk_fwd, dim3(grid), dim3(512), LDS_BYTES, stream, a); }
#endif
}
```
